# Optimizing an MI355X kernel written in HIP

```python
import math
import jax
import jax.numpy as jnp
from jax import lax
import numpy as np

D_MODEL = 2048
BATCH = 4
SEQ = 4096
DEPTH = 1

GRID_W = 64
CTX_LEN = 256
EPS = 1e-6
ATT_HEADS = 16
ATT_KV_HEADS = 4
HEAD_DIM = 64
D_ATT = ATT_HEADS * HEAD_DIM
D_KV = ATT_KV_HEADS * HEAD_DIM
WINDOW = 128
BLOCK = 128
ROPE_THETA = 10000.0
SSD_HEADS = 16
SSD_HEAD_DIM = 64
D_SSD = SSD_HEADS * SSD_HEAD_DIM
SSD_GROUPS = 4
SSD_HPG = SSD_HEADS // SSD_GROUPS
D_STATE = 128
D_XBC = D_SSD + 2 * SSD_GROUPS * D_STATE
CONV_W = 3
CHUNK = 128
D_MIX = D_ATT + D_SSD
N_IN = 2 * D_ATT + 2 * D_KV + D_SSD + D_XBC + 2 * SSD_HEADS
SPLIT_IDX = (D_ATT, D_ATT + D_KV, D_ATT + 2 * D_KV, 2 * D_ATT + 2 * D_KV, 2 * D_ATT + 2 * D_KV + D_SSD, 2 * D_ATT + 2 * D_KV + D_SSD + D_XBC, 2 * D_ATT + 2 * D_KV + D_SSD + D_XBC + SSD_HEADS)

kernel_name = 'hybrid_swa_ssd_prefix_dit_layer'


def rmsnorm(x, g):
    xf = x.astype(jnp.float32)
    y = xf * lax.rsqrt(jnp.mean(xf * xf, axis=-1, keepdims=True) + EPS)
    return (y * g.astype(jnp.float32)).astype(x.dtype)


def axial_rope(t):
    n = t.shape[1]
    rows = n // GRID_W
    row = jnp.repeat(jnp.arange(rows), GRID_W).astype(jnp.float32)
    col = jnp.tile(jnp.arange(GRID_W), rows).astype(jnp.float32)
    half = HEAD_DIM // 2
    quarter = half // 2
    freq = 1.0 / (ROPE_THETA ** (jnp.arange(quarter, dtype=jnp.float32) / quarter))

    def rot(u, pos):
        ang = pos[:, None] * freq[None, :]
        cos = jnp.cos(ang)[None, :, None, :].astype(u.dtype)
        sin = jnp.sin(ang)[None, :, None, :].astype(u.dtype)
        u1, u2 = u[..., :quarter], u[..., quarter:]
        return jnp.concatenate([u1 * cos - u2 * sin, u2 * cos + u1 * sin], axis=-1)

    return jnp.concatenate([rot(t[..., :half], row), rot(t[..., half:], col)], axis=-1)


def band_blocks(t, nb):
    b, _, h, d = t.shape
    tp = jnp.pad(t, ((0, 0), (BLOCK, BLOCK), (0, 0), (0, 0))).reshape(b, nb + 2, BLOCK, h, d)
    return jnp.concatenate([tp[:, :-2], tp[:, 1:-1], tp[:, 2:]], axis=2)


def windowed_gqa(q, k, v, k_ctx, v_ctx, sink):
    b, s, h, hd = q.shape
    kvh = k.shape[2]
    grp = h // kvh
    nb = s // BLOCK
    nl = 3 * BLOCK
    nctx = k_ctx.shape[1]
    scale = hd ** -0.5
    qb = q.reshape(b, nb, BLOCK, kvh, grp, hd)
    kw, vw = band_blocks(k, nb), band_blocks(v, nb)
    s_loc = jnp.einsum('bnqkgd,bnjkd->bnkgqj', qb, kw).astype(jnp.float32) * scale
    s_ctx = jnp.einsum('bnqkgd,bckd->bnkgqc', qb, k_ctx).astype(jnp.float32) * scale
    qi = jnp.arange(BLOCK)[:, None]
    kj = jnp.arange(nl)[None, :]
    kpos = (jnp.arange(nb)[:, None, None] - 1) * BLOCK + kj
    valid = (jnp.abs(kj - BLOCK - qi) <= WINDOW) & (kpos >= 0) & (kpos < s)
    s_loc = jnp.where(valid[None, :, None, None], s_loc, -jnp.inf)
    s_sink = jnp.broadcast_to(sink.astype(jnp.float32).reshape(1, 1, kvh, grp, 1, 1), s_loc.shape[:-1] + (1,))
    p = jax.nn.softmax(jnp.concatenate([s_loc, s_ctx, s_sink], axis=-1), axis=-1).astype(v.dtype)
    o = jnp.einsum('bnkgqj,bnjkd->bnqkgd', p[..., :nl], vw) + jnp.einsum('bnkgqc,bckd->bnqkgd', p[..., nl:nl + nctx], v_ctx)
    return o.reshape(b, s, h * hd)


def ctx_attention(q, k, v, sink):
    b, n, h, hd = q.shape
    kvh = k.shape[2]
    grp = h // kvh
    qg = q.reshape(b, n, kvh, grp, hd)
    s = jnp.einsum('bqkgd,bckd->bkgqc', qg, k).astype(jnp.float32) * hd ** -0.5
    s_sink = jnp.broadcast_to(sink.astype(jnp.float32).reshape(1, kvh, grp, 1, 1), s.shape[:-1] + (1,))
    p = jax.nn.softmax(jnp.concatenate([s, s_sink], axis=-1), axis=-1)[..., :-1].astype(v.dtype)
    o = jnp.einsum('bkgqc,bckd->bqkgd', p, v)
    return o.reshape(b, n, h * hd)


def segsum(a):
    cs = jnp.cumsum(a, axis=-1)
    t = a.shape[-1]
    mask = jnp.tril(jnp.ones((t, t), dtype=bool))
    return jnp.where(mask, cs[..., :, None] - cs[..., None, :], -jnp.inf)


def ssd_scan(x, dt, a, bm, cm, h0):
    b, l, g, r, p = x.shape
    n = bm.shape[-1]
    nc = l // CHUNK
    xf = x.astype(jnp.float32).reshape(b, nc, CHUNK, g, r, p)
    dtc = dt.reshape(b, nc, CHUNK, g, r)
    bc = bm.astype(jnp.float32).reshape(b, nc, CHUNK, g, n)
    cc = cm.astype(jnp.float32).reshape(b, nc, CHUNK, g, n)
    xdt = xf * dtc[..., None]
    a_t = jnp.moveaxis(dtc * a, (1, 2), (3, 4))
    a_cs = jnp.cumsum(a_t, axis=-1)
    cb = jnp.einsum('bclgn,bcsgn->bgcls', cc, bc)
    wts = cb[:, :, None] * jnp.exp(segsum(a_t))
    y_diag = jnp.einsum('bgrcls,bcsgrp->bclgrp', wts, xdt)
    decay_states = jnp.exp(a_cs[..., -1:] - a_cs)
    states = jnp.einsum('bclgn,bgrcl,bclgrp->bcgrpn', bc, decay_states, xdt)
    states = jnp.concatenate([h0[:, None], states], axis=1)
    a_last = jnp.pad(a_cs[..., -1], ((0, 0), (0, 0), (0, 0), (1, 0)))
    decay_chunk = jnp.exp(segsum(a_last))
    new_states = jnp.einsum('bgrzc,bcgrpn->bzgrpn', decay_chunk, states)
    prev, final = new_states[:, :-1], new_states[:, -1]
    y_off = jnp.einsum('bclgn,bcgrpn,bgrcl->bclgrp', cc, prev, jnp.exp(a_cs))
    return (y_diag + y_off).reshape(b, l, g, r, p), final


def dwconv(u, w, bias):
    out = lax.conv_general_dilated(u, w[:, None, :], window_strides=(1,), padding=[(CONV_W // 2, CONV_W // 2)], dimension_numbers=('NWC', 'WIO', 'NWC'), feature_group_count=u.shape[-1])
    return out + bias


def ssd_inputs(xbc, dt_f, dt_b, conv_w, conv_b, dt_bias_f, dt_bias_b):
    b, n, _ = xbc.shape
    u = jax.nn.silu(dwconv(xbc, conv_w, conv_b))
    xs, bm, cm = jnp.split(u, [D_SSD, D_SSD + SSD_GROUPS * D_STATE], axis=-1)
    xs = xs.reshape(b, n, SSD_GROUPS, SSD_HPG, SSD_HEAD_DIM)
    bm = bm.reshape(b, n, SSD_GROUPS, D_STATE)
    cm = cm.reshape(b, n, SSD_GROUPS, D_STATE)
    dtf = jax.nn.softplus((dt_f + dt_bias_f).astype(jnp.float32)).reshape(b, n, SSD_GROUPS, SSD_HPG)
    dtb = jax.nn.softplus((dt_b + dt_bias_b).astype(jnp.float32)).reshape(b, n, SSD_GROUPS, SSD_HPG)
    return xs, bm, cm, dtf, dtb


def bi_ssd(xs, bm, cm, dtf, dtb, a_f, a_b, d_skip, h0_f, h0_b):
    flip = lambda t: jnp.flip(t, axis=1)
    y_f, h_f = ssd_scan(xs, dtf, a_f, bm, cm, h0_f)
    y_b, h_b = ssd_scan(flip(xs), flip(dtb), a_b, flip(bm), flip(cm), h0_b)
    y = y_f + flip(y_b) + xs.astype(jnp.float32) * d_skip.astype(jnp.float32).reshape(SSD_GROUPS, SSD_HPG, 1)
    b, n = xs.shape[:2]
    return y.astype(xs.dtype).reshape(b, n, D_SSD), h_f, h_b


def merge_groups(att, g_att, y, z, att_norm_g, ssd_norm_g, w_out):
    h = jnp.concatenate([rmsnorm(att * jax.nn.silu(g_att), att_norm_g), rmsnorm(y * jax.nn.silu(z), ssd_norm_g)], axis=-1)
    return h @ w_out


def hybrid_layer(x, ctx, c, c_ctx, w_mod, b_mod, norm_g, w_in, conv_w, conv_b, a_log_f, a_log_b, dt_bias_f, dt_bias_b, d_skip, att_norm_g, ssd_norm_g, sink, w_out, update_ctx):
    b, s, _ = x.shape
    nc = ctx.shape[1]
    shift, scale, gate = jnp.split((jax.nn.silu(c) @ w_mod + b_mod)[:, None, :], 3, axis=-1)
    shift_c, scale_c, gate_c = jnp.split(jax.nn.silu(c_ctx) @ w_mod + b_mod, 3, axis=-1)
    px = (rmsnorm(x, norm_g) * (1 + scale) + shift) @ w_in
    pc = (rmsnorm(ctx, norm_g) * (1 + scale_c) + shift_c) @ w_in
    qx, kx, vx, gx, zx, xbcx, dtfx, dtbx = jnp.split(px, list(SPLIT_IDX), axis=-1)
    qc, kc, vc, gc, zc, xbcc, dtfc, dtbc = jnp.split(pc, list(SPLIT_IDX), axis=-1)
    kc_h = kc.reshape(b, nc, ATT_KV_HEADS, HEAD_DIM)
    vc_h = vc.reshape(b, nc, ATT_KV_HEADS, HEAD_DIM)
    qx_h = axial_rope(qx.reshape(b, s, ATT_HEADS, HEAD_DIM))
    kx_h = axial_rope(kx.reshape(b, s, ATT_KV_HEADS, HEAD_DIM))
    vx_h = vx.reshape(b, s, ATT_KV_HEADS, HEAD_DIM)
    att_x = windowed_gqa(qx_h, kx_h, vx_h, kc_h, vc_h, sink)
    a_f = -jnp.exp(a_log_f.astype(jnp.float32)).reshape(SSD_GROUPS, SSD_HPG)
    a_b = -jnp.exp(a_log_b.astype(jnp.float32)).reshape(SSD_GROUPS, SSD_HPG)
    xs_c, bm_c, cm_c, dtf_c, dtb_c = ssd_inputs(xbcc, dtfc, dtbc, conv_w, conv_b, dt_bias_f, dt_bias_b)
    h0 = jnp.zeros((b, SSD_GROUPS, SSD_HPG, SSD_HEAD_DIM, D_STATE), jnp.float32)
    y_c, h_cf, h_cb = bi_ssd(xs_c, bm_c, cm_c, dtf_c, dtb_c, a_f, a_b, d_skip, h0, h0)
    xs_x, bm_x, cm_x, dtf_x, dtb_x = ssd_inputs(xbcx, dtfx, dtbx, conv_w, conv_b, dt_bias_f, dt_bias_b)
    y_x, _, _ = bi_ssd(xs_x, bm_x, cm_x, dtf_x, dtb_x, a_f, a_b, d_skip, h_cf, h_cb)
    x = x + gate * merge_groups(att_x, gx, y_x, zx, att_norm_g, ssd_norm_g, w_out)
    if update_ctx:
        att_c = ctx_attention(qc.reshape(b, nc, ATT_HEADS, HEAD_DIM), kc_h, vc_h, sink)
        ctx = ctx + gate_c * merge_groups(att_c, gc, y_c, zc, att_norm_g, ssd_norm_g, w_out)
    return x, ctx


def setup_inputs(seed: int = 0) -> dict:
    key = jax.random.key(seed)
    ks = jax.random.split(key, 20)
    f32 = jnp.float32
    nrm = lambda k, shape, sc: jax.random.normal(k, shape, f32) * sc
    dt0 = jnp.exp(jax.random.uniform(ks[10], (2, DEPTH, SSD_HEADS), f32, math.log(1e-3), math.log(1e-1)))
    dt_bias = dt0 + jnp.log(-jnp.expm1(-dt0))
    a_log = jnp.log(jax.random.uniform(ks[11], (2, DEPTH, SSD_HEADS), f32, 1.0, 16.0))
    return {
        'x': nrm(ks[0], (BATCH, SEQ, D_MODEL), 1.0),
        'c': nrm(ks[1], (BATCH, D_MODEL), 1.0),
        'ctx': nrm(ks[2], (BATCH, CTX_LEN, D_MODEL), 1.0),
        'c_ctx': nrm(ks[3], (D_MODEL,), 1.0),
        'w_mod': nrm(ks[4], (DEPTH, D_MODEL, 3 * D_MODEL), 0.5 * D_MODEL ** -0.5),
        'b_mod': nrm(ks[5], (DEPTH, 3 * D_MODEL), 0.01),
        'norm_g': 1.0 + nrm(ks[6], (DEPTH, D_MODEL), 0.02),
        'w_in': nrm(ks[7], (DEPTH, D_MODEL, N_IN), D_MODEL ** -0.5),
        'conv_w': nrm(ks[8], (DEPTH, CONV_W, D_XBC), CONV_W ** -0.5),
        'conv_b': nrm(ks[9], (DEPTH, D_XBC), 0.01),
        'a_log_f': a_log[0],
        'a_log_b': a_log[1],
        'dt_bias_f': dt_bias[0],
        'dt_bias_b': dt_bias[1],
        'd_skip': 1.0 + nrm(ks[12], (DEPTH, SSD_HEADS), 0.02),
        'att_norm_g': 1.0 + nrm(ks[13], (DEPTH, D_ATT), 0.02),
        'ssd_norm_g': 1.0 + nrm(ks[14], (DEPTH, D_SSD), 0.02),
        'sink': nrm(ks[15], (DEPTH, ATT_HEADS), 0.5),
        'w_out': nrm(ks[16], (DEPTH, D_MIX, D_MODEL), D_MIX ** -0.5),
        'final_norm_g': 1.0 + nrm(ks[17], (D_MODEL,), 0.02),
    }


def reference(x, c, ctx, c_ctx, w_mod, b_mod, norm_g, w_in, conv_w, conv_b, a_log_f, a_log_b, dt_bias_f, dt_bias_b, d_skip, att_norm_g, ssd_norm_g, sink, w_out, final_norm_g):
    for l in range(DEPTH):
        x, ctx = hybrid_layer(x, ctx, c, c_ctx, w_mod[l], b_mod[l], norm_g[l], w_in[l], conv_w[l], conv_b[l], a_log_f[l], a_log_b[l], dt_bias_f[l], dt_bias_b[l], d_skip[l], att_norm_g[l], ssd_norm_g[l], sink[l], w_out[l], l < DEPTH - 1)
    return rmsnorm(x, final_norm_g)
```

```cpp
#include <hip/hip_runtime.h>
#include <hip/hip_cooperative_groups.h>
#include <cstdio>
namespace cg = cooperative_groups;

#ifndef MK_LAUNCHES
#define MK_LAUNCHES 1
#endif

#define DBG_W(x) (x)
#define LAS __attribute__((address_space(3)))
typedef unsigned short bf16_t;
typedef short bf16x8 __attribute__((ext_vector_type(8)));
typedef float f32x4 __attribute__((ext_vector_type(4)));
typedef unsigned u32x4 __attribute__((ext_vector_type(4)));
typedef unsigned u32x2 __attribute__((ext_vector_type(2)));

constexpr int DM = 2048, NB = 4, SEQ = 4096, NCTX = 256;
constexpr int NX = NB * SEQ;
constexpr int NR = NX + NB * NCTX;
constexpr int NIN = 5664, NMAIN = 5632;
constexpr int TOKP = SEQ + NCTX;
constexpr int NSLOT = 34;
constexpr float QSCALE = 0.125f * 1.4426950408889634f;
constexpr float LOG2E = 1.4426950408889634f;
constexpr float EPS = 1e-6f;
constexpr int LDS_BYTES = 147456;

constexpr size_t al256(size_t x) { return (x + 255) & ~(size_t)255; }
constexpr size_t WS_MOD = 0;
constexpr size_t WS_ROPEC = al256(WS_MOD + 5 * 6144 * 4);
constexpr size_t WS_ROPES = al256(WS_ROPEC + 64 * 16 * 4);
constexpr size_t WS_DEC = al256(WS_ROPES + 64 * 16 * 4);
constexpr size_t WS_WINT = al256(WS_DEC + 4 * 2 * NSLOT * 16 * 4);
constexpr size_t WS_WDTT = al256(WS_WINT + (size_t)NMAIN * DM * 2);
constexpr size_t WS_WOUTT = al256(WS_WDTT + 32 * DM * 2);
constexpr size_t WS_XN = al256(WS_WOUTT + (size_t)DM * DM * 2);
constexpr size_t WS_CS = WS_XN;
constexpr size_t WS_QB = al256(WS_XN + (size_t)NR * DM * 2);
constexpr size_t WS_RB = WS_QB;
constexpr size_t WS_KB = al256(WS_QB + (size_t)NX * 1024 * 2);
constexpr size_t WS_VT = al256(WS_KB + (size_t)NR * 256 * 2);
constexpr size_t WS_GS = al256(WS_VT + (size_t)NB * 4 * 64 * TOKP * 2);
constexpr size_t WS_ZS = al256(WS_GS + (size_t)NX * 1024 * 2);
constexpr size_t WS_XBC = al256(WS_ZS + (size_t)NX * 1024 * 2);
constexpr size_t WS_PS = WS_XBC;
constexpr size_t WS_DT = al256(WS_XBC + (size_t)NR * DM * 2);
constexpr size_t WS_XT = al256(WS_DT + (size_t)NR * 32 * 4);
constexpr size_t WS_BT = al256(WS_XT + (size_t)NB * 1024 * TOKP * 2);
constexpr size_t WS_BCN = al256(WS_BT + (size_t)NB * 512 * TOKP * 2);
constexpr size_t WS_HRAW = al256(WS_BCN + (size_t)NR * 1024 * 2);
constexpr size_t WS_BAR = al256(WS_HRAW + (size_t)NX * DM * 2);
constexpr size_t WS_SSQA = al256(WS_BAR + 3456 * 4);
constexpr size_t WS_SSQS = al256(WS_SSQA + (size_t)NX * 16 * 4);
constexpr size_t WS_END = al256(WS_SSQS + (size_t)NX * 16 * 4);
static_assert((size_t)NB * 2 * NSLOT * 16 * 8192 * 2 <= (size_t)NR * DM * 2, "CS/PS alias size");
static_assert(WS_QB + (size_t)NX * DM * 2 <= WS_ZS, "RB alias must end before ZS (read by phase 6)");

struct Params {
    const float *x, *c, *ctx, *c_ctx, *w_mod, *b_mod, *norm_g, *w_in, *conv_w, *conv_b, *a_log_f, *a_log_b, *dt_bias_f, *dt_bias_b, *d_skip,
        *att_norm_g, *ssd_norm_g, *sink, *w_out, *final_norm_g;
    float* out; unsigned char* ws; int ph_lo, ph_hi;
};

typedef float f32x2 __attribute__((ext_vector_type(2)));
typedef __bf16 bf16x2_t __attribute__((ext_vector_type(2)));
__device__ __forceinline__ unsigned pk2(float lo, float hi) { const f32x2 v = {lo, hi}; const bf16x2_t r = __builtin_convertvector(v, bf16x2_t); return __builtin_bit_cast(unsigned, r); }
__device__ __forceinline__ float bflo(unsigned u) { return __uint_as_float(u << 16); }
__device__ __forceinline__ float bfhi(unsigned u) { return __uint_as_float(u & 0xffff0000u); }
__device__ __forceinline__ float siluf(float v) { return v * __builtin_amdgcn_rcpf(1.0f + __expf(-v)); }
__device__ __forceinline__ float wave_sum(float v) {
#pragma unroll
    for (int o = 32; o >= 1; o >>= 1) v += __shfl_xor(v, o);
    return v;
}
__device__ __forceinline__ int opaque_tid() { int t = threadIdx.x; asm volatile("" : "+v"(t)); return t; }
#define MFMA16(a, b, c) __builtin_amdgcn_mfma_f32_16x16x32_bf16((a), (b), (c), 0, 0, 0)
union U8 { u32x4 u; bf16x8 h; };

namespace pg8 {
constexpr int BM = 256, BK = 64, HALF = 128, HTB = HALF * BK * 2, STAGE_BYTES = 8 * HTB, NXCD = 8, WGM = 8;
__device__ __forceinline__ int lds_byte(int r, int c) { const int st = (r >> 4) * 2 + (c >> 5), rr = r & 15, cc = c & 31, ob = rr * 64 + cc * 2; return st * 1024 + (ob ^ (((ob >> 9) & 1) << 5)); }
__device__ __forceinline__ void stage_rc(int b, int& R, int& C) { const int st = b / 1024, sb = b % 1024, swz = sb ^ (((sb >> 9) & 1) << 5); R = (st >> 1) * 16 + swz / 64; C = (st & 1) * 32 + (swz % 64) / 2; }
__device__ __forceinline__ int perm32(int rho) { const int n = rho >> 4, i = rho & 15; return 8 * (i >> 2) + 4 * n + (i & 3); }
struct Unit { int pm, pn; };
struct Gemm { const bf16_t* A; const bf16_t* Bt; int M, N, K; };
__device__ __forceinline__ void static_map(int wgid, int nM, int nN, Unit& u, int WGM = 8) {
    const int nwg = nM * nN;
    { const int q = nwg / NXCD, r = nwg % NXCD, xcd = wgid % NXCD, off = wgid / NXCD; wgid = (xcd < r ? xcd * (q + 1) : r * (q + 1) + (xcd - r) * q) + off; }
    const int nig = WGM * nN, gid = wgid / nig, fm = gid * WGM, gsz = (nM - fm) < WGM ? (nM - fm) : WGM;
    u.pm = fm + ((wgid % nig) % gsz); u.pn = (wgid % nig) / gsz;
}
struct StaticOrder {
    int nM, nN, nwg, G, c;
    __device__ void init(int M, int N, int G_, int c_) { nM = M / BM; nN = N / BM; nwg = nM * nN; G = G_; c = c_; }
    __device__ bool next(int i, Unit& u) const { const long L = (long)i * G + c; if (L >= nwg) return false; static_map((int)L, nM, nN, u, 4); return true; }
};
struct OrderIn {
    int G, c;
    __device__ bool next(int i, Unit& u) const {
        const long L = (long)i * G + c; if (L >= 1448) return false;
        if (L < 1408) { static_map((int)L, 64, 22, u, 4); }
        else { const int e = (int)L - 1408, j = e % 10; u.pm = 64 + e / 10; u.pn = (j == 0) ? 4 : (j == 1) ? 5 : 12 + j; }
        return true;
    }
};

template <class Epi, class Sched>
__device__ __forceinline__ void gemm_phase(LAS unsigned char* lds, const Gemm g, const Sched& S, const Epi& E) {
    const int tid = opaque_tid(), wid = __builtin_amdgcn_readfirstlane(tid >> 6), lane = tid & 63, wr = wid >> 2, wc = wid & 3, fr = lane & 15, fq = lane >> 4;
    const int K = g.K, nt = K / BK;
    unsigned voffA[2], voffB[2];
#pragma unroll
    for (int i = 0; i < 2; ++i) { int R, C; stage_rc(tid * 16 + i * 8192, R, C); const int Rb = Epi::PERM ? ((R & ~31) + perm32(R & 31)) : R;
        voffA[i] = (unsigned)(R * K + C) * 2u; voffB[i] = (unsigned)(Rb * K + C) * 2u; }
    const size_t kstep = (size_t)(BK * 2);
    const size_t hstep = (size_t)HALF * K * 2;
    const size_t tstep = 2 * hstep;
    const unsigned ldsw = (unsigned)wid * 1024u;
    const int aoff = lds_byte(wr * 64 + fr, fq * 8), boff = lds_byte(wc * 32 + fr, fq * 8);
#define PG8_SA(b, h) (((b) * 2 + (h)) * HTB)
#define PG8_SB(b, h) ((4 + (b) * 2 + (h)) * HTB)
#define PG8_STAGE(bufoff, gbase, voff) do { _Pragma("unroll") for (int _i = 0; _i < 2; ++_i) \
        __builtin_amdgcn_global_load_lds((const unsigned*)((const char*)(gbase) + (voff)[_i]), (LAS unsigned*)(lds + (bufoff) + ldsw + _i * 8192), 16, 0, 0); } while (0)
#define PG8_LDA(dst, b, h) do { _Pragma("unroll") for (int m = 0; m < 4; ++m) _Pragma("unroll") for (int k = 0; k < 2; ++k) dst[m][k] = *(const LAS bf16x8*)(lds + PG8_SA(b, h) + aoff + m * 2048 + k * 1024); } while (0)
#define PG8_LDB(dst, b, h) do { _Pragma("unroll") for (int n = 0; n < 2; ++n) _Pragma("unroll") for (int k = 0; k < 2; ++k) dst[n][k] = *(const LAS bf16x8*)(lds + PG8_SB(b, h) + boff + n * 2048 + k * 1024); } while (0)
#define PG8_MMA(ai, bj, At, Bt) do { __builtin_amdgcn_s_setprio(1); _Pragma("unroll") for (int m = 0; m < 4; ++m) _Pragma("unroll") for (int n = 0; n < 2; ++n) _Pragma("unroll") for (int k = 0; k < 2; ++k) \
        acc[ai][bj][m][n] = __builtin_amdgcn_mfma_f32_16x16x32_bf16(Bt[n][k], At[m][k], acc[ai][bj][m][n], 0, 0, 0); __builtin_amdgcn_s_setprio(0); } while (0)
#define PG8_WAIT_V(n) asm volatile("s_waitcnt vmcnt(" #n ")" ::: "memory")
#define PG8_WAIT_L(n) asm volatile("s_waitcnt lgkmcnt(" #n ")" ::: "memory")
#define PG8_BAR __builtin_amdgcn_s_barrier()
#define PG8_SCHED __builtin_amdgcn_sched_barrier(0)
    Unit cur, nxt; int ui = 0;
    if (!S.next(0, cur)) return;
    f32x4 acc[2][2][4][2];
#pragma unroll
    for (int a = 0; a < 2; ++a)
#pragma unroll
        for (int b = 0; b < 2; ++b)
#pragma unroll
            for (int m = 0; m < 4; ++m)
#pragma unroll
                for (int n = 0; n < 2; ++n) acc[a][b][m][n] = (f32x4){0.f, 0.f, 0.f, 0.f};
    bf16x8 At[4][2], B0[2][2], B1[2][2];
    const char* cA = (const char*)g.A + (size_t)cur.pm * tstep; const char* cB = (const char*)g.Bt + (size_t)cur.pn * tstep;
    PG8_STAGE(PG8_SB(0, 0), cB, voffB); PG8_STAGE(PG8_SA(0, 0), cA, voffA); PG8_STAGE(PG8_SB(0, 1), cB + hstep, voffB); PG8_STAGE(PG8_SA(0, 1), cA + hstep, voffA);
    if (wr == 1) PG8_BAR;
    PG8_WAIT_V(4); PG8_BAR;
    PG8_STAGE(PG8_SB(1, 0), cB + kstep, voffB); PG8_STAGE(PG8_SA(1, 0), cA + kstep, voffA); PG8_STAGE(PG8_SB(1, 1), cB + hstep + kstep, voffB);
    PG8_WAIT_V(6); PG8_BAR;
    for (;;) {
        const bool has_next = S.next(ui + 1, nxt);
        const char* nA = has_next ? (const char*)g.A + (size_t)nxt.pm * tstep : cA; const char* nB = has_next ? (const char*)g.Bt + (size_t)nxt.pn * tstep : cB;
        for (int t = 0; t < nt; t += 2) {
            if (Epi::MIDK && t == nt / 2) E.midk(acc, ui, wr, fr);
            const bool last = (t == nt - 2);
            const char* a1 = cA + (size_t)(t + 1) * kstep;
            const char* a2 = last ? nA : cA + (size_t)(t + 2) * kstep; const char* b2 = last ? nB : cB + (size_t)(t + 2) * kstep;
            const char* a3 = a2 + kstep; const char* b3 = b2 + kstep;
            PG8_LDB(B0, 0, 0); PG8_SCHED; PG8_LDA(At, 0, 0); PG8_STAGE(PG8_SA(1, 1), a1 + hstep, voffA);
            PG8_WAIT_L(8); PG8_BAR; PG8_WAIT_L(0); PG8_MMA(0, 0, At, B0); PG8_BAR; PG8_SCHED;
            PG8_LDB(B1, 0, 1); PG8_STAGE(PG8_SB(0, 0), b2, voffB);
            PG8_BAR; PG8_WAIT_L(0); PG8_MMA(0, 1, At, B1); PG8_BAR;
            PG8_LDA(At, 0, 1); PG8_STAGE(PG8_SA(0, 0), a2, voffA);
            PG8_BAR; PG8_WAIT_L(0); PG8_MMA(1, 0, At, B0); PG8_BAR; PG8_SCHED;
            PG8_STAGE(PG8_SB(0, 1), b2 + hstep, voffB);
            PG8_WAIT_V(6); PG8_BAR; PG8_MMA(1, 1, At, B1); PG8_BAR;
            PG8_LDB(B0, 1, 0); PG8_SCHED; PG8_LDA(At, 1, 0); PG8_STAGE(PG8_SA(0, 1), a2 + hstep, voffA);
            PG8_WAIT_L(8); PG8_BAR; PG8_WAIT_L(0); PG8_MMA(0, 0, At, B0); PG8_BAR; PG8_SCHED;
            PG8_LDB(B1, 1, 1); PG8_STAGE(PG8_SB(1, 0), b3, voffB);
            PG8_BAR; PG8_WAIT_L(0); PG8_MMA(0, 1, At, B1); PG8_BAR;
            PG8_LDA(At, 1, 1); PG8_STAGE(PG8_SA(1, 0), a3, voffA);
            PG8_BAR; PG8_WAIT_L(0); PG8_MMA(1, 0, At, B0); PG8_BAR; PG8_SCHED;
            PG8_STAGE(PG8_SB(1, 1), b3 + hstep, voffB);
            PG8_WAIT_V(6); PG8_BAR; PG8_MMA(1, 1, At, B1); PG8_BAR;
        }
        E(acc, cur, ui, wr, wc, fr, fq);
        if (!has_next) break;
#pragma unroll
        for (int a = 0; a < 2; ++a)
#pragma unroll
            for (int b = 0; b < 2; ++b)
#pragma unroll
                for (int m = 0; m < 4; ++m)
#pragma unroll
                    for (int n = 0; n < 2; ++n) acc[a][b][m][n] = (f32x4){0.f, 0.f, 0.f, 0.f};
        cur = nxt; cA = nA; cB = nB; ++ui;
    }
    PG8_WAIT_V(0);
    if (wr == 0) PG8_BAR;
    PG8_BAR;
#undef PG8_SA
#undef PG8_SB
#undef PG8_STAGE
#undef PG8_LDA
#undef PG8_LDB
#undef PG8_MMA
#undef PG8_WAIT_V
#undef PG8_WAIT_L
#undef PG8_BAR
#undef PG8_SCHED
}
}

struct EpiIn {
    static constexpr bool PERM = true, MIDK = false;
    unsigned char* ws; const float *ropeC, *ropeS;
    __device__ __forceinline__ void midk(f32x4 (&)[2][2][4][2], int, int, int) const {}
    __device__ __forceinline__ void operator()(const f32x4 (&acc)[2][2][4][2], const pg8::Unit& u, int, int wr, int wc, int fr, int fq) const {
        asm volatile("" : "+v"(fr), "+v"(fq));
        const int pn = u.pn;
        const int rowb = u.pm * 256 + wr * 64 + fr;
        const int colw = wc * 32 + 8 * fq;
#ifndef EPI_NO_ROPE
        if (pn <= 4) {
            const bool isq = pn < 4, ctxrow = u.pm >= 64;
            bf16_t* base = (bf16_t*)(ws + (isq ? WS_QB : WS_KB)); const int ld = isq ? 1024 : 256, cbase = isq ? pn * 256 : 0;
            const float sc = isq ? QSCALE : 1.0f, sgn = (fq < 2) ? -1.0f : 1.0f;
#pragma unroll
            for (int ai = 0; ai < 2; ++ai)
#pragma unroll
                for (int m = 0; m < 4; ++m) { __builtin_amdgcn_sched_barrier(0);
                    const int row = rowb + ai * 128 + m * 16, s = row & 4095, pos = (wc & 1) ? (s & 63) : (s >> 6);
                    f32x4 c0 = *(const f32x4*)(ropeC + pos * 16 + 8 * (fq & 1)), c1 = *(const f32x4*)(ropeC + pos * 16 + 8 * (fq & 1) + 4);
                    f32x4 s0 = *(const f32x4*)(ropeS + pos * 16 + 8 * (fq & 1)), s1 = *(const f32x4*)(ropeS + pos * 16 + 8 * (fq & 1) + 4);
                    if (ctxrow) { c0 = c1 = (f32x4){1.f, 1.f, 1.f, 1.f}; s0 = s1 = (f32x4){0.f, 0.f, 0.f, 0.f}; }
#pragma unroll
                    for (int bj = 0; bj < 2; ++bj) {
                        const f32x4 v0 = acc[ai][bj][m][0], v1 = acc[ai][bj][m][1]; f32x4 p0, p1;
#pragma unroll
                        for (int j = 0; j < 4; ++j) { p0[j] = __shfl_xor(v0[j], 32); p1[j] = __shfl_xor(v1[j], 32); }
                        const f32x4 o0 = (v0 * c0 + sgn * p0 * s0) * sc, o1 = (v1 * c1 + sgn * p1 * s1) * sc;
                        u32x4 w; w.x = pk2(o0[0], o0[1]); w.y = pk2(o0[2], o0[3]); w.z = pk2(o1[0], o1[1]); w.w = pk2(o1[2], o1[3]);
                        *(u32x4*)(base + (size_t)row * ld + cbase + bj * 128 + colw) = w;
                        __builtin_amdgcn_sched_barrier(0);
                    }
                }
        } else
#endif
#ifndef EPI_NO_V
        if (pn == 5) {
            bf16_t* VT = (bf16_t*)(ws + WS_VT);
#pragma unroll
            for (int ai = 0; ai < 2; ++ai)
#pragma unroll
                for (int m = 0; m < 4; ++m) { __builtin_amdgcn_sched_barrier(0);
                    const int row = rowb + ai * 128 + m * 16;
                    int b, s; if (row < NX) { b = row >> 12; s = row & 4095; } else { b = (row - NX) >> 8; s = SEQ + ((row - NX) & 255); }
#pragma unroll
                    for (int bj = 0; bj < 2; ++bj)
#pragma unroll
                        for (int n = 0; n < 2; ++n)
#pragma unroll
                            for (int j = 0; j < 4; ++j) {
                                const int col = bj * 128 + colw + 4 * n + j;
                                VT[((size_t)(b * 4 + (col >> 6)) * 64 + (col & 63)) * TOKP + s] = (bf16_t)(pk2(acc[ai][bj][m][n][j], 0.f) & 0xffffu);
                            }
                }
        } else
#endif
        {
            const bool act = pn < 14;
            bf16_t* base = (bf16_t*)(ws + ((pn < 10) ? WS_GS : (pn < 14) ? WS_ZS : WS_XBC));
            const int ld = act ? 1024 : 2048, cbase = (pn < 10) ? (pn - 6) * 256 : (pn < 14) ? (pn - 10) * 256 : (pn - 14) * 256;
#pragma unroll
            for (int ai = 0; ai < 2; ++ai)
#pragma unroll
                for (int m = 0; m < 4; ++m) { __builtin_amdgcn_sched_barrier(0);
                    const int row = rowb + ai * 128 + m * 16;
#pragma unroll
                    for (int bj = 0; bj < 2; ++bj) {
                        f32x4 v0 = acc[ai][bj][m][0], v1 = acc[ai][bj][m][1];
                        if (act) {
#pragma unroll
                            for (int j = 0; j < 4; ++j) { v0[j] = siluf(v0[j]); v1[j] = siluf(v1[j]); }
                        }
                        u32x4 w; w.x = pk2(v0[0], v0[1]); w.y = pk2(v0[2], v0[3]); w.z = pk2(v1[0], v1[1]); w.w = pk2(v1[2], v1[3]);
                        *(u32x4*)(base + (size_t)row * ld + cbase + bj * 128 + colw) = w;
                        __builtin_amdgcn_sched_barrier(0);
                    }
                }
        }
    }
};
constexpr int RAT_OFF = 131072, RSY_OFF = 131072 + 6 * 256 * 4, MAX_OUT_UNITS = 6;
struct EpiOut {
    static constexpr bool PERM = true, MIDK = true;
    const float* x; const float* mod; bf16_t* rb; LAS unsigned char* lds;
    __device__ __forceinline__ void midk(f32x4 (&acc)[2][2][4][2], int ui, int wr, int fr) const {
        const LAS float* rat = (const LAS float*)(lds + RAT_OFF) + ui * 256 + wr * 64 + fr;
#pragma unroll
        for (int ai = 0; ai < 2; ++ai)
#pragma unroll
            for (int m = 0; m < 4; ++m) {
                const float r = rat[ai * 128 + m * 16];
#pragma unroll
                for (int bj = 0; bj < 2; ++bj)
#pragma unroll
                    for (int n = 0; n < 2; ++n) acc[ai][bj][m][n] *= r;
            }
    }
    __device__ __forceinline__ void operator()(const f32x4 (&acc)[2][2][4][2], const pg8::Unit& u, int ui, int wr, int wc, int fr, int fq) const {
        asm volatile("" : "+v"(fr), "+v"(fq));
        const int row0 = u.pm * 256 + wr * 64 + fr, col0 = u.pn * 256 + wc * 32 + 8 * fq;
        const int b = (u.pm * 256) >> 12;
        const LAS float* rsy = (const LAS float*)(lds + RSY_OFF) + ui * 256 + wr * 64 + fr;
        f32x4 gv[2][2];
#pragma unroll
        for (int bj = 0; bj < 2; ++bj)
#pragma unroll
            for (int n = 0; n < 2; ++n) gv[bj][n] = *(const f32x4*)(mod + b * 6144 + 4096 + col0 + bj * 128 + n * 4);
#pragma unroll
        for (int ai = 0; ai < 2; ++ai) {
            f32x4 xv[4][2][2];
#pragma unroll
            for (int m = 0; m < 4; ++m) {
                const size_t ro = (size_t)(row0 + ai * 128 + m * 16) * DM + col0;
#pragma unroll
                for (int bj = 0; bj < 2; ++bj) { xv[m][bj][0] = __builtin_nontemporal_load((const f32x4*)(x + ro + bj * 128)); xv[m][bj][1] = __builtin_nontemporal_load((const f32x4*)(x + ro + bj * 128 + 4)); }
            }
            __builtin_amdgcn_sched_barrier(0);
#pragma unroll
            for (int m = 0; m < 4; ++m) {
                const size_t ro = (size_t)(row0 + ai * 128 + m * 16) * DM + col0;
                const float ry = rsy[ai * 128 + m * 16];
#pragma unroll
                for (int bj = 0; bj < 2; ++bj) {
                    const f32x4 r0 = xv[m][bj][0] + gv[bj][0] * (ry * acc[ai][bj][m][0]), r1 = xv[m][bj][1] + gv[bj][1] * (ry * acc[ai][bj][m][1]);
                    u32x4 w; w.x = pk2(r0[0], r0[1]); w.y = pk2(r0[2], r0[3]); w.z = pk2(r1[0], r1[1]); w.w = pk2(r1[2], r1[3]);
                    *(u32x4*)(rb + ro + bj * 128) = w;
                }
            }
            __builtin_amdgcn_sched_barrier(0);
        }
    }
};

__device__ __forceinline__ void p0_mod_item(const Params& p, LAS unsigned char* lds, int item) {
    LAS float* sc = (LAS float*)lds;
    LAS float* red = (LAS float*)(lds + 5 * 2048 * 4);
    const int tid = opaque_tid(), c0 = item * 32;
    for (int idx = tid; idx < 5 * 2048; idx += 512) { const int b = idx >> 11, k = idx & 2047; const float v = (b < 4) ? p.c[b * 2048 + k] : p.c_ctx[k]; sc[idx] = siluf(v); }
    __syncthreads();
    const int rr = tid >> 3, pc = tid & 7;
    f32x4 a[5];
#pragma unroll
    for (int b = 0; b < 5; ++b) a[b] = (f32x4){0.f, 0.f, 0.f, 0.f};
    const float* wp = p.w_mod + (size_t)rr * 6144 + c0 + 4 * pc;
#pragma unroll 8
    for (int i = 0; i < 32; ++i) {
        const f32x4 w = __builtin_nontemporal_load((const f32x4*)(wp + (size_t)i * 64 * 6144));
        const int row = i * 64 + rr;
#pragma unroll
        for (int b = 0; b < 5; ++b) a[b] += sc[b * 2048 + row] * w;
    }
#pragma unroll
    for (int b = 0; b < 5; ++b)
#pragma unroll
        for (int j = 0; j < 4; ++j) red[(rr * 8 + pc) * 20 + b * 4 + j] = a[b][j];
    __syncthreads();
    if (tid < 160) {
        const int b = tid >> 5, col = tid & 31, pcc = col >> 2, j = col & 3; float s = 0.f;
        for (int r = 0; r < 64; ++r) s += red[(r * 8 + pcc) * 20 + b * 4 + j];
        ((float*)(p.ws + WS_MOD))[b * 6144 + c0 + col] = s + p.b_mod[c0 + col];
    }
    __syncthreads();
}
__device__ __forceinline__ void p0_transpose_item(LAS unsigned char* lds, const float* src, int ldn, int k0, int n0, bf16_t* dst) {
    LAS float* T = (LAS float*)lds;
    const int tid = opaque_tid();
    f32x4 v[4];
#pragma unroll
    for (int i = 0; i < 4; ++i) { const int idx = tid + 512 * i, kr = idx >> 5, q = idx & 31; v[i] = __builtin_nontemporal_load((const f32x4*)(src + (size_t)(k0 + kr) * ldn + n0 + 4 * q)); }
#pragma unroll
    for (int i = 0; i < 4; ++i) { const int idx = tid + 512 * i, kr = idx >> 5, q = idx & 31;
#pragma unroll
        for (int j = 0; j < 4; ++j) T[(4 * q + j) * 65 + kr] = v[i][j]; }
    __syncthreads();
#pragma unroll
    for (int i = 0; i < 2; ++i) {
        const int idx = tid + 512 * i, n = idx >> 3, ks = idx & 7;
        float f[8];
#pragma unroll
        for (int e = 0; e < 8; ++e) f[e] = T[n * 65 + ks * 8 + e];
        u32x4 w; w.x = pk2(f[0], f[1]); w.y = pk2(f[2], f[3]); w.z = pk2(f[4], f[5]); w.w = pk2(f[6], f[7]);
        *(u32x4*)(dst + (size_t)(n0 + n) * 2048 + k0 + ks * 8) = w;
    }
    __syncthreads();
}
__device__ __forceinline__ void phase0(const Params& p, LAS unsigned char* lds) {
    bf16_t* WINT = (bf16_t*)(p.ws + WS_WINT); bf16_t* WDTT = (bf16_t*)(p.ws + WS_WDTT); bf16_t* WOUTT = (bf16_t*)(p.ws + WS_WOUTT);
    const int tid = opaque_tid();
    constexpr int N_MOD = 192, N_TIN = 1408, N_TOUT = 512, N_TDT = 32, N_ROPE = 1;
    constexpr int TOTAL = N_MOD + N_TIN + N_TOUT + N_TDT + N_ROPE;
    for (int item = blockIdx.x; item < TOTAL; item += gridDim.x) {
        int it = item;
        if (it < N_MOD) { p0_mod_item(p, lds, it); continue; }
        it -= N_MOD;
        if (it < N_TIN) { p0_transpose_item(lds, p.w_in, NIN, (it & 31) * 64, (it >> 5) * 128, WINT); continue; }
        it -= N_TIN;
        if (it < N_TOUT) { p0_transpose_item(lds, p.w_out, DM, (it & 31) * 64, (it >> 5) * 128, WOUTT); continue; }
        it -= N_TOUT;
        if (it < N_TDT) {
            const int k0 = it * 64;
#pragma unroll
            for (int i = 0; i < 4; ++i) { const int idx = tid + 512 * i, n = idx & 31, kr = idx >> 5;
                WDTT[(size_t)n * 2048 + k0 + kr] = (bf16_t)(pk2(p.w_in[(size_t)(k0 + kr) * NIN + NMAIN + n], 0.f) & 0xffffu); }
            continue;
        }
        {
            float* rc = (float*)(p.ws + WS_ROPEC); float* rs = (float*)(p.ws + WS_ROPES);
            for (int idx = tid; idx < 1024; idx += 512) {
                const int pos = idx >> 4, i = idx & 15;
                const float freq = 1.0f / powf(10000.0f, (float)i / 16.0f), ang = (float)pos * freq;
                rc[idx] = cosf(ang); rs[idx] = sinf(ang);
            }
        }
    }
}

__device__ __forceinline__ void phase1(const Params& p) {
    const float* mod = (const float*)(p.ws + WS_MOD); bf16_t* XN = (bf16_t*)(p.ws + WS_XN);
    const int tid_ = opaque_tid(), lane = tid_ & 63, wid = tid_ >> 6;
    const int stride = gridDim.x * 8;
    for (int row0 = blockIdx.x * 8 + wid; row0 < NR; row0 += 2 * stride) {
        f32x4 v[2][8]; float ss[2] = {0.f, 0.f};
#pragma unroll
        for (int r = 0; r < 2; ++r) {
            const int row = (row0 + r * stride < NR) ? row0 + r * stride : row0;
            const float* src = (row < NX) ? p.x + (size_t)row * DM : p.ctx + (size_t)(row - NX) * DM;
#pragma unroll
            for (int i = 0; i < 8; ++i) v[r][i] = __builtin_nontemporal_load((const f32x4*)(src + (i * 64 + lane) * 4));
        }
#pragma unroll
        for (int r = 0; r < 2; ++r) {
#pragma unroll
            for (int i = 0; i < 8; ++i) ss[r] += v[r][i][0] * v[r][i][0] + v[r][i][1] * v[r][i][1] + v[r][i][2] * v[r][i][2] + v[r][i][3] * v[r][i][3];
            ss[r] = wave_sum(ss[r]);
        }
#pragma unroll
        for (int r = 0; r < 2; ++r) {
            const int row = row0 + r * stride;
            if (row < NR) {
                const int b = (row < NX) ? (row >> 12) : 4;
                const float rstd = rsqrtf(ss[r] * (1.0f / DM) + EPS);
#pragma unroll
                for (int i = 0; i < 8; ++i) {
                    const int k = (i * 64 + lane) * 4;
                    const f32x4 g = *(const f32x4*)(p.norm_g + k), sh = *(const f32x4*)(mod + b * 6144 + k), scl = *(const f32x4*)(mod + b * 6144 + 2048 + k);
                    const f32x4 y = (v[r][i] * rstd * g) * (1.0f + scl) + sh;
                    u32x2 w; w.x = pk2(y[0], y[1]); w.y = pk2(y[2], y[3]);
                    *(u32x2*)(XN + (size_t)row * DM + k) = w;
                }
            }
        }
    }
}

__device__ __forceinline__ float softplusf(float v) { return v > 20.0f ? v : log1pf(__expf(v)); }
__device__ __forceinline__ void phase2_dt(const Params& p) {
    const bf16_t* XN = (const bf16_t*)(p.ws + WS_XN); const bf16_t* WDTT = (const bf16_t*)(p.ws + WS_WDTT); float* DT = (float*)(p.ws + WS_DT);
    const int tid_ = opaque_tid(), lane = tid_ & 63, wid = tid_ >> 6, fr = lane & 15, fq = lane >> 4;
    const int G = (int)gridDim.x, nfull = 1448 % G, nlight = G - nfull;
    if ((int)blockIdx.x < nfull) return;
    for (int task = ((int)blockIdx.x - nfull) * 8 + wid; task < NR / 16; task += 8 * nlight) {
        const int r0 = task * 16;
        f32x4 a0 = (f32x4){0.f, 0.f, 0.f, 0.f}, a1 = a0;
        const bf16_t* xa = XN + (size_t)(r0 + fr) * DM + fq * 8;
        const bf16_t* w0 = WDTT + (size_t)fr * DM + fq * 8; const bf16_t* w1 = WDTT + (size_t)(16 + fr) * DM + fq * 8;
#pragma unroll 8
        for (int ks = 0; ks < 64; ++ks) {
            const bf16x8 av = *(const bf16x8*)(xa + ks * 32), b0 = *(const bf16x8*)(w0 + ks * 32), b1 = *(const bf16x8*)(w1 + ks * 32);
            a0 = MFMA16(b0, av, a0); a1 = MFMA16(b1, av, a1);
        }
        const f32x4 bf = *(const f32x4*)(p.dt_bias_f + 4 * fq), bb = *(const f32x4*)(p.dt_bias_b + 4 * fq);
        f32x4 of, ob;
#pragma unroll
        for (int j = 0; j < 4; ++j) { of[j] = softplusf(a0[j] + bf[j]); ob[j] = softplusf(a1[j] + bb[j]); }
        *(f32x4*)(DT + (size_t)(r0 + fr) * 32 + 4 * fq) = of; *(f32x4*)(DT + (size_t)(r0 + fr) * 32 + 16 + 4 * fq) = ob;
    }
}

__device__ __forceinline__ void attn_phase(const Params& p, LAS unsigned char* lds, int n_items) {
    const bf16_t* QB = (const bf16_t*)(p.ws + WS_QB); const bf16_t* KB = (const bf16_t*)(p.ws + WS_KB); const bf16_t* VT = (const bf16_t*)(p.ws + WS_VT);
    const bf16_t* GS = (const bf16_t*)(p.ws + WS_GS); bf16_t* HRAW = (bf16_t*)(p.ws + WS_HRAW);
    const int tid = opaque_tid(), lane = tid & 63, wid = tid >> 6, fr = lane & 15, fq = lane >> 4;
    const int wq = wid & 3, wq_u = __builtin_amdgcn_readfirstlane(wq);
    u32x4 kreg[2], vreg[2];
    bf16x8 qf[2][2];
    auto tile_src = [&](int item_, int tt, size_t& krow0, int& s0, int& j) {
        const int n_ = (item_ >> 3) & 31, b_ = item_ >> 8;
        if (tt < 2) { krow0 = (size_t)NX + b_ * NCTX + tt * 128; s0 = SEQ + tt * 128; j = 1; }
        else { j = ((n_ == 0) ? 1 : 0) + (tt - 2); const int kb = n_ - 1 + j; krow0 = (size_t)b_ * SEQ + kb * 128; s0 = kb * 128; }
    };
    auto gload = [&](int item_, int tt) {
        size_t krow0; int s0, j; tile_src(item_, tt, krow0, s0, j);
        const int kvh_ = (item_ & 7) >> 1, b_ = item_ >> 8;
#pragma unroll
        for (int i = 0; i < 2; ++i) {
            const int idx = tid + 512 * i;
            { const int key = idx >> 3, sl = idx & 7; kreg[i] = *(const u32x4*)(KB + (krow0 + key) * 256 + kvh_ * 64 + sl * 8); }
            { const int d = idx >> 4, sl = idx & 15; vreg[i] = *(const u32x4*)(VT + ((size_t)(b_ * 4 + kvh_) * 64 + d) * TOKP + s0 + sl * 8); }
        }
    };
    auto lstore = [&](int buf) {
#pragma unroll
        for (int i = 0; i < 2; ++i) {
            const int idx = tid + 512 * i;
            { const int key = idx >> 3, sl = idx & 7; *(LAS u32x4*)(lds + buf * 16384 + key * 128 + ((sl ^ (key & 7)) << 4)) = kreg[i]; }
            { const int d = idx >> 4, sl = idx & 15, kb_ = sl >> 2, s_ = sl & 3, hf_ = (s_ >> 1) * 8;
              LAS unsigned char* vrow = lds + 32768 + buf * 16384 + d * 256;
              *(LAS u32x2*)(vrow + (((kb_ * 4 + ((2 * s_) & 3)) ^ (d & 15)) << 4) + hf_) = (u32x2){vreg[i].x, vreg[i].y};
              *(LAS u32x2*)(vrow + (((kb_ * 4 + ((2 * s_ + 1) & 3)) ^ (d & 15)) << 4) + hf_) = (u32x2){vreg[i].z, vreg[i].w}; }
        }
    };
    auto qload = [&](int item_, bf16x8 (&q)[2][2]) {
        const int hp_ = item_ & 7, n_ = (item_ >> 3) & 31, b_ = item_ >> 8, h_ = hp_ * 2 + (wid >> 2);
#pragma unroll
        for (int qs = 0; qs < 2; ++qs)
#pragma unroll
            for (int ks = 0; ks < 2; ++ks)
                q[qs][ks] = *(const bf16x8*)(QB + (size_t)(b_ * SEQ + n_ * 128 + wq * 32 + qs * 16 + fr) * 1024 + h_ * 64 + ks * 32 + fq * 8);
    };
    int par = 0;
    int item = blockIdx.x;
    if (item < n_items) { qload(item, qf); gload(item, 0); lstore(0); }
    __syncthreads();
    for (; item < n_items; item += gridDim.x) {
    const int hp = item & 7, n = (item >> 3) & 31, b = item >> 8;
    const int h = hp * 2 + (wid >> 2);
    const int T = 5 - (n == 0) - (n == 31);
    const int nxt = item + (int)gridDim.x; const bool has_next = nxt < n_items;
    f32x4 oacc[4][2];
#pragma unroll
    for (int d = 0; d < 4; ++d)
#pragma unroll
        for (int qs = 0; qs < 2; ++qs) oacc[d][qs] = (f32x4){0.f, 0.f, 0.f, 0.f};
    float mrun[2] = {0.f, 0.f}, lrun[2] = {0.f, 0.f};
    for (int tt = 0; tt < T; ++tt) {
        const int buf = (tt + par) & 1;
        if (tt + 1 < T) gload(item, tt + 1);
        else if (has_next) gload(nxt, 0);
        size_t krow0_; int s0_, j; tile_src(item, tt, krow0_, s0_, j);
        LAS unsigned char* Kl = lds + buf * 16384; LAS unsigned char* Vl = lds + 32768 + buf * 16384;
        f32x4 sacc[8][2];
        __builtin_amdgcn_s_setprio(1);
#pragma unroll
        for (int kt = 0; kt < 8; ++kt) {
            sacc[kt][0] = (f32x4){-mrun[0], -mrun[0], -mrun[0], -mrun[0]}; sacc[kt][1] = (f32x4){-mrun[1], -mrun[1], -mrun[1], -mrun[1]};
#pragma unroll
            for (int ks = 0; ks < 2; ++ks) {
                const bf16x8 kf = *(const LAS bf16x8*)(Kl + (kt * 16 + fr) * 128 + (((ks * 4 + fq) ^ (fr & 7)) << 4));
                sacc[kt][0] = MFMA16(kf, qf[0][ks], sacc[kt][0]); sacc[kt][1] = MFMA16(kf, qf[1][ks], sacc[kt][1]);
            }
        }
        __builtin_amdgcn_s_setprio(0);
        if (j != 1) {
            int frm = fr, fqm = fq; asm volatile("" : "+v"(frm), "+v"(fqm));
            const int e0 = 4 * fqm - frm;
#pragma unroll
            for (int qs = 0; qs < 2; ++qs) {
                const int kd = 2 * wq_u + qs;
#pragma unroll
                for (int kt = 0; kt < 8; ++kt) {
                    const bool dead = (j == 0) ? (kt < kd) : (kt > kd);
                    if (dead) { sacc[kt][qs] = (f32x4){-INFINITY, -INFINITY, -INFINITY, -INFINITY}; }
                    else if (kt == kd) {
#pragma unroll
                        for (int jj = 0; jj < 4; ++jj) {
                            const bool ok = (j == 0) ? (e0 + jj >= 0) : (e0 + jj <= 0);
                            if (!ok) sacc[kt][qs][jj] = -INFINITY;
                        }
                    }
                }
            }
        }
        float mx[2];
#pragma unroll
        for (int qs = 0; qs < 2; ++qs) {
            float m_ = -INFINITY;
#pragma unroll
            for (int kt = 0; kt < 8; ++kt)
#pragma unroll
                for (int jj = 0; jj < 4; ++jj) m_ = fmaxf(m_, sacc[kt][qs][jj]);
            m_ = fmaxf(m_, __shfl_xor(m_, 16)); m_ = fmaxf(m_, __shfl_xor(m_, 32));
            mx[qs] = m_;
        }
        if (!__all(fmaxf(mx[0], mx[1]) <= 8.0f)) {
#pragma unroll
            for (int qs = 0; qs < 2; ++qs) {
                const float delta = fmaxf(mx[qs], 0.0f), alpha = __builtin_amdgcn_exp2f(-delta);
                mrun[qs] += delta; lrun[qs] *= alpha;
#pragma unroll
                for (int d = 0; d < 4; ++d) oacc[d][qs] *= alpha;
#pragma unroll
                for (int kt = 0; kt < 8; ++kt)
#pragma unroll
                    for (int jj = 0; jj < 4; ++jj) sacc[kt][qs][jj] -= delta;
            }
        }
        bf16x8 pf[4][2];
#pragma unroll
        for (int qs = 0; qs < 2; ++qs) {
            float ls = 0.f;
#pragma unroll
            for (int kt = 0; kt < 8; ++kt)
#pragma unroll
                for (int jj = 0; jj < 4; ++jj) { const float e = __builtin_amdgcn_exp2f(sacc[kt][qs][jj]); sacc[kt][qs][jj] = e; ls += e; }
            lrun[qs] += ls;
#pragma unroll
            for (int kb = 0; kb < 4; ++kb) {
                U8 t; t.u.x = pk2(sacc[2 * kb][qs][0], sacc[2 * kb][qs][1]); t.u.y = pk2(sacc[2 * kb][qs][2], sacc[2 * kb][qs][3]);
                t.u.z = pk2(sacc[2 * kb + 1][qs][0], sacc[2 * kb + 1][qs][1]); t.u.w = pk2(sacc[2 * kb + 1][qs][2], sacc[2 * kb + 1][qs][3]);
                pf[kb][qs] = t.h;
            }
        }
        if (tt + 1 == T && has_next) qload(nxt, qf);
        __builtin_amdgcn_s_setprio(1);
#pragma unroll
        for (int kb = 0; kb < 4; ++kb)
#pragma unroll
            for (int d = 0; d < 4; ++d) {
                U8 vf; vf.u = *(const LAS u32x4*)(Vl + (d * 16 + fr) * 256 + (((4 * kb + fq) ^ fr) << 4));
                oacc[d][0] = MFMA16(vf.h, pf[kb][0], oacc[d][0]); oacc[d][1] = MFMA16(vf.h, pf[kb][1], oacc[d][1]);
            }
        __builtin_amdgcn_s_setprio(0);
        if (tt + 1 < T || has_next) lstore(buf ^ 1);
        __syncthreads();
    }
    par = (par + T) & 1;
    const float sk2 = p.sink[h] * LOG2E;
    int fre = fr, fqe = fq; asm volatile("" : "+v"(fre), "+v"(fqe));
    u32x2 gsv[2][4]; f32x4 ngv[4];
#pragma unroll
    for (int d = 0; d < 4; ++d) {
        ngv[d] = *(const f32x4*)(p.att_norm_g + h * 64 + d * 16 + 4 * fqe);
#pragma unroll
        for (int qs = 0; qs < 2; ++qs) gsv[qs][d] = *(const u32x2*)(GS + ((size_t)b * SEQ + n * 128 + wq * 32 + qs * 16 + fre) * 1024 + h * 64 + d * 16 + 4 * fqe);
    }
    __builtin_amdgcn_sched_barrier(0);
#pragma unroll
    for (int qs = 0; qs < 2; ++qs) {
        float l = lrun[qs]; l += __shfl_xor(l, 16); l += __shfl_xor(l, 32);
        l += __builtin_amdgcn_exp2f(sk2 - mrun[qs]);
        const float inv = 1.0f / l;
        const size_t row = (size_t)b * SEQ + n * 128 + wq * 32 + qs * 16 + fre;
        float sq = 0.f;
#pragma unroll
        for (int d = 0; d < 4; ++d) {
            const int col = h * 64 + d * 16 + 4 * fqe;
            const u32x2 g = gsv[qs][d];
            const f32x4 ng = ngv[d];
            const float v0 = oacc[d][qs][0] * inv * bflo(g.x), v1 = oacc[d][qs][1] * inv * bfhi(g.x), v2 = oacc[d][qs][2] * inv * bflo(g.y), v3 = oacc[d][qs][3] * inv * bfhi(g.y);
            sq += v0 * v0 + v1 * v1 + v2 * v2 + v3 * v3;
            u32x2 w; w.x = pk2(v0 * ng[0], v1 * ng[1]); w.y = pk2(v2 * ng[2], v3 * ng[3]);
            *(u32x2*)(HRAW + row * DM + col) = w;
        }
        sq += __shfl_xor(sq, 16); sq += __shfl_xor(sq, 32);
        if (fq == 0) ((float*)(p.ws + WS_SSQA))[row * 16 + h] = sq;
    }
    }
}

__device__ __forceinline__ void conv_phase(const Params& p, LAS unsigned char* lds) {
    const bf16_t* XBC = (const bf16_t*)(p.ws + WS_XBC); bf16_t* XT = (bf16_t*)(p.ws + WS_XT); bf16_t* BT = (bf16_t*)(p.ws + WS_BT); bf16_t* BCN = (bf16_t*)(p.ws + WS_BCN);
    const int tid = opaque_tid();
    const int G16 = (int)gridDim.x >> 4;
    if ((int)blockIdx.x >= G16 * 16) return;
    const int cb = blockIdx.x & 15, ch0 = cb * 128;
    const int t = tid & 31, cs = tid >> 5, ch = ch0 + cs * 8;
    float w0[8], w1[8], w2[8], wb[8];
#pragma unroll
    for (int e = 0; e < 8; ++e) { w0[e] = p.conv_w[ch + e]; w1[e] = p.conv_w[DM + ch + e]; w2[e] = p.conv_w[2 * DM + ch + e]; wb[e] = p.conv_b[ch + e]; }
    LAS unsigned char* R = lds;
    LAS unsigned char* Tt = lds + 18432;
    LAS unsigned char* Nn = lds + 18432 + 18432;
    u32x4 raw[3];
    auto tile_info = [&](int tt, int& b, int& tok0, int& seqlen, int& rowbase, int& sbase) {
        if (tt < 256) { b = tt >> 6; tok0 = (tt & 63) * 64; seqlen = SEQ; rowbase = b * SEQ; sbase = 0; }
        else { const int t2 = tt - 256; b = t2 >> 2; tok0 = (t2 & 3) * 64; seqlen = NCTX; rowbase = NX + b * NCTX; sbase = SEQ; }
    };
    auto gload = [&](int tt) {
        int b, tok0, seqlen, rowbase, sbase; tile_info(tt, b, tok0, seqlen, rowbase, sbase);
#pragma unroll
        for (int i = 0; i < 3; ++i) {
            const int idx = tid + 512 * i, rr = idx >> 4, sl = idx & 15, tok = tok0 - 1 + rr;
            raw[i] = (u32x4){0u, 0u, 0u, 0u};
            if (idx < 66 * 16 && tok >= 0 && tok < seqlen) raw[i] = *(const u32x4*)(XBC + (size_t)(rowbase + tok) * DM + ch0 + sl * 8);
        }
    };
    int tt = blockIdx.x >> 4;
    gload(tt);
    for (; tt < 272; tt += G16) {
        int b, tok0, seqlen, rowbase, sbase; tile_info(tt, b, tok0, seqlen, rowbase, sbase);
#pragma unroll
        for (int i = 0; i < 3; ++i) { const int idx = tid + 512 * i, rr = idx >> 4, sl = idx & 15; if (idx < 66 * 16) *(LAS u32x4*)(R + rr * 272 + sl * 16) = raw[i]; }
        __syncthreads();
        if (tt + G16 < 272) gload(tt + G16);
        {
            u32x4 r[4];
#pragma unroll
            for (int i = 0; i < 4; ++i) r[i] = *(const LAS u32x4*)(R + (2 * t + i) * 272 + cs * 16);
            float u0[8], u1[8];
#pragma unroll
            for (int e2 = 0; e2 < 4; ++e2) {
                float x[4][2];
#pragma unroll
                for (int i = 0; i < 4; ++i) { x[i][0] = bflo(r[i][e2]); x[i][1] = bfhi(r[i][e2]); }
#pragma unroll
                for (int hh = 0; hh < 2; ++hh) {
                    const int e = e2 * 2 + hh;
                    u0[e] = siluf(wb[e] + w0[e] * x[0][hh] + w1[e] * x[1][hh] + w2[e] * x[2][hh]);
                    u1[e] = siluf(wb[e] + w0[e] * x[1][hh] + w1[e] * x[2][hh] + w2[e] * x[3][hh]);
                }
            }
            if (cb < 12) {
#pragma unroll
                for (int e = 0; e < 8; ++e) *(LAS unsigned*)(Tt + (cs * 8 + e) * 144 + t * 4) = pk2(u0[e], u1[e]);
            }
            if (cb >= 8) {
                u32x4 o0, o1;
                o0.x = pk2(u0[0], u0[1]); o0.y = pk2(u0[2], u0[3]); o0.z = pk2(u0[4], u0[5]); o0.w = pk2(u0[6], u0[7]);
                o1.x = pk2(u1[0], u1[1]); o1.y = pk2(u1[2], u1[3]); o1.z = pk2(u1[4], u1[5]); o1.w = pk2(u1[6], u1[7]);
                *(LAS u32x4*)(Nn + (2 * t) * 272 + cs * 16) = o0; *(LAS u32x4*)(Nn + (2 * t + 1) * 272 + cs * 16) = o1;
            }
        }
        __syncthreads();
        if (cb < 12) {
            bf16_t* dst = (cb < 8) ? XT + ((size_t)b * 1024 + ch0) * TOKP : BT + ((size_t)b * 512 + (ch0 - 1024)) * TOKP;
#pragma unroll
            for (int i = 0; i < 2; ++i) {
                const int idx = tid + 512 * i, chl = idx >> 3, sl = idx & 7;
                *(u32x4*)(dst + (size_t)chl * TOKP + sbase + tok0 + sl * 8) = *(const LAS u32x4*)(Tt + chl * 144 + sl * 16);
            }
        }
        if (cb >= 8) {
#pragma unroll
            for (int i = 0; i < 2; ++i) {
                const int idx = tid + 512 * i, tk = idx >> 4, sl = idx & 15;
                *(u32x4*)(BCN + (size_t)(rowbase + tok0 + tk) * 1024 + (ch0 - 1024) + sl * 8) = *(const LAS u32x4*)(Nn + tk * 272 + sl * 16);
            }
        }
    }
    __syncthreads();
}

__device__ __forceinline__ float chunk_tables_hd(const Params& p, LAS float* tab, int row0, int hg, int dir);
__device__ __forceinline__ float chunk_tables(const Params& p, LAS float* tab, int row0, int g) {
    const int w = opaque_tid() >> 6;
    return chunk_tables_hd(p, tab, row0, g * 4 + (w >> 1), w & 1);
}
__device__ __forceinline__ float chunk_tables_hd(const Params& p, LAS float* tab, int row0, int hg, int dir) {
    const float* DT = (const float*)(p.ws + WS_DT);
    const int tid_ = opaque_tid(), lane = tid_ & 63, w = tid_ >> 6;
    const float A = -__expf(dir ? p.a_log_b[hg] : p.a_log_f[hg]);
    const float d0 = DT[(size_t)(row0 + 2 * lane) * 32 + dir * 16 + hg], d1 = DT[(size_t)(row0 + 2 * lane + 1) * 32 + dir * 16 + hg];
    const float a0 = d0 * A, a1 = d1 * A;
    float inc = a0 + a1;
#pragma unroll
    for (int o = 1; o < 64; o <<= 1) { const float t = __shfl_up(inc, o); if (lane >= o) inc += t; }
    const float total = __shfl(inc, 63);
    float c0 = inc - a1, c1 = inc;
    if (dir) { c0 = total - c0 + a0; c1 = total - c1 + a1; }
    LAS float* tb = tab + w * 256;
    tb[2 * lane] = c0; tb[2 * lane + 1] = c1; tb[128 + 2 * lane] = d0; tb[128 + 2 * lane + 1] = d1;
    return total;
}

__device__ __forceinline__ void s1_item(const Params& p, LAS unsigned char* lds, int item) {
    const bf16_t* XT = (const bf16_t*)(p.ws + WS_XT); const bf16_t* BT = (const bf16_t*)(p.ws + WS_BT);
    bf16_t* CS = (bf16_t*)(p.ws + WS_CS); float* DEC = (float*)(p.ws + WS_DEC);
    const int tid = opaque_tid(), lane = tid & 63, w = tid >> 6, fr = lane & 15, fq = lane >> 4;
    const int g = item & 3, cid = (item >> 2) % NSLOT, b = (item >> 2) / NSLOT;
    int row0, s0, slot_f, slot_b;
    if (cid < 2) { row0 = NX + b * NCTX + cid * 128; s0 = SEQ + cid * 128; slot_f = cid; slot_b = 1 - cid; }
    else { const int c = cid - 2; row0 = b * SEQ + c * 128; s0 = c * 128; slot_f = 2 + c; slot_b = 2 + (31 - c); }
    LAS unsigned char* Xl = lds;
    LAS unsigned char* Bl = lds + 65536;
    LAS float* tab = (LAS float*)(lds + 98304);
    LAS float* wS = (LAS float*)(lds + 98304 + 8192);
#pragma unroll
    for (int i = 0; i < 8; ++i) { const int idx = tid + 512 * i, r = idx >> 4, sl = idx & 15;
        *(LAS u32x4*)(Xl + r * 256 + ((sl ^ (r & 15)) << 4)) = *(const u32x4*)(XT + ((size_t)b * 1024 + g * 256 + r) * TOKP + s0 + sl * 8); }
#pragma unroll
    for (int i = 0; i < 4; ++i) { const int idx = tid + 512 * i, r = idx >> 4, sl = idx & 15, rs = (r & ~31) + pg8::perm32(r & 31);
        *(LAS u32x4*)(Bl + r * 256 + ((sl ^ (r & 15)) << 4)) = *(const u32x4*)(BT + ((size_t)b * 512 + g * 128 + rs) * TOKP + s0 + sl * 8); }
    const float total = chunk_tables(p, tab, row0, g);
    const int hl = w >> 1, dir = w & 1, hg = g * 4 + hl, slot = dir ? slot_b : slot_f;
    {
        LAS float* tb = tab + w * 256;
#pragma unroll
        for (int i = 0; i < 2; ++i) { const int l = 2 * lane + i; wS[w * 128 + l] = DBG_W(tb[128 + l] * __expf(total - tb[l])); }
        if (lane == 0) DEC[((b * 2 + dir) * NSLOT + slot) * 16 + hg] = __expf(total);
    }
    __syncthreads();
    bf16_t* dst = CS + ((size_t)((b * 2 + dir) * NSLOT + slot) * 16 + hg) * 8192;
#pragma unroll 1
    for (int pt = 0; pt < 4; ++pt) {
        f32x4 acc[8];
#pragma unroll
        for (int nt = 0; nt < 8; ++nt) acc[nt] = (f32x4){0.f, 0.f, 0.f, 0.f};
#pragma unroll
        for (int ks = 0; ks < 4; ++ks) {
            const int xr = hl * 64 + pt * 16 + fr;
            U8 xa; xa.u = *(const LAS u32x4*)(Xl + xr * 256 + (((ks * 4 + fq) ^ fr) << 4));
            const f32x4 wa = *(const LAS f32x4*)(wS + w * 128 + ks * 32 + fq * 8), wb = *(const LAS f32x4*)(wS + w * 128 + ks * 32 + fq * 8 + 4);
            xa.u.x = pk2(bflo(xa.u.x) * wa[0], bfhi(xa.u.x) * wa[1]); xa.u.y = pk2(bflo(xa.u.y) * wa[2], bfhi(xa.u.y) * wa[3]);
            xa.u.z = pk2(bflo(xa.u.z) * wb[0], bfhi(xa.u.z) * wb[1]); xa.u.w = pk2(bflo(xa.u.w) * wb[2], bfhi(xa.u.w) * wb[3]);
#pragma unroll
            for (int nt = 0; nt < 8; ++nt) {
                const bf16x8 bb = *(const LAS bf16x8*)(Bl + (nt * 16 + fr) * 256 + (((ks * 4 + fq) ^ fr) << 4));
                acc[nt] = MFMA16(bb, xa.h, acc[nt]);
            }
        }
#pragma unroll
        for (int k2 = 0; k2 < 4; ++k2) {
            u32x4 o; o.x = pk2(acc[2 * k2][0], acc[2 * k2][1]); o.y = pk2(acc[2 * k2][2], acc[2 * k2][3]); o.z = pk2(acc[2 * k2 + 1][0], acc[2 * k2 + 1][1]); o.w = pk2(acc[2 * k2 + 1][2], acc[2 * k2 + 1][3]);
            *(u32x4*)(dst + (pt * 16 + fr) * 128 + k2 * 32 + 8 * fq) = o;
        }
    }
    __syncthreads();
}

__device__ __forceinline__ void s1_ctx_item(const Params& p, LAS unsigned char* lds, int sub) {
    const bf16_t* XT = (const bf16_t*)(p.ws + WS_XT); const bf16_t* BT = (const bf16_t*)(p.ws + WS_BT);
    bf16_t* CS = (bf16_t*)(p.ws + WS_CS); float* DEC = (float*)(p.ws + WS_DEC);
    const int tid = opaque_tid(), lane = tid & 63, w = tid >> 6, fr = lane & 15, fq = lane >> 4;
    const int dir = sub & 1, hl = (sub >> 1) & 3, g = (sub >> 3) & 3, cid = (sub >> 5) & 1, b = sub >> 6, hg = g * 4 + hl;
    const int row0 = NX + b * NCTX + cid * 128, s0 = SEQ + cid * 128, slot = dir ? (1 - cid) : cid;
    LAS unsigned char* Xl = lds;
    LAS unsigned char* Bl = lds + 65536;
    LAS float* tab = (LAS float*)(lds + 98304);
    LAS float* wS = (LAS float*)(lds + 98304 + 8192);
#pragma unroll
    for (int i = 0; i < 2; ++i) { const int idx = tid + 512 * i, r = idx >> 4, sl = idx & 15;
        *(LAS u32x4*)(Xl + r * 256 + ((sl ^ (r & 15)) << 4)) = *(const u32x4*)(XT + ((size_t)b * 1024 + hg * 64 + r) * TOKP + s0 + sl * 8); }
#pragma unroll
    for (int i = 0; i < 4; ++i) { const int idx = tid + 512 * i, r = idx >> 4, sl = idx & 15, rs = (r & ~31) + pg8::perm32(r & 31);
        *(LAS u32x4*)(Bl + r * 256 + ((sl ^ (r & 15)) << 4)) = *(const u32x4*)(BT + ((size_t)b * 512 + g * 128 + rs) * TOKP + s0 + sl * 8); }
    const float total = chunk_tables_hd(p, tab, row0, hg, dir);
    {
        LAS float* tb = tab + w * 256;
#pragma unroll
        for (int i = 0; i < 2; ++i) { const int l = 2 * lane + i; wS[w * 128 + l] = tb[128 + l] * __expf(total - tb[l]); }
        if (tid == 0) DEC[((b * 2 + dir) * NSLOT + slot) * 16 + hg] = __expf(total);
    }
    __syncthreads();
    bf16_t* dst = CS + ((size_t)((b * 2 + dir) * NSLOT + slot) * 16 + hg) * 8192;
    const int pt = w >> 1, nt0 = (w & 1) * 4;
    f32x4 acc[4];
#pragma unroll
    for (int nt = 0; nt < 4; ++nt) acc[nt] = (f32x4){0.f, 0.f, 0.f, 0.f};
#pragma unroll
    for (int ks = 0; ks < 4; ++ks) {
        U8 xa; xa.u = *(const LAS u32x4*)(Xl + (pt * 16 + fr) * 256 + (((ks * 4 + fq) ^ fr) << 4));
        const f32x4 wa = *(const LAS f32x4*)(wS + w * 128 + ks * 32 + fq * 8), wb = *(const LAS f32x4*)(wS + w * 128 + ks * 32 + fq * 8 + 4);
        xa.u.x = pk2(bflo(xa.u.x) * wa[0], bfhi(xa.u.x) * wa[1]); xa.u.y = pk2(bflo(xa.u.y) * wa[2], bfhi(xa.u.y) * wa[3]);
        xa.u.z = pk2(bflo(xa.u.z) * wb[0], bfhi(xa.u.z) * wb[1]); xa.u.w = pk2(bflo(xa.u.w) * wb[2], bfhi(xa.u.w) * wb[3]);
#pragma unroll
        for (int nt = 0; nt < 4; ++nt) {
            const bf16x8 bb = *(const LAS bf16x8*)(Bl + ((nt0 + nt) * 16 + fr) * 256 + (((ks * 4 + fq) ^ fr) << 4));
            acc[nt] = MFMA16(bb, xa.h, acc[nt]);
        }
    }
#pragma unroll
    for (int k2 = 0; k2 < 2; ++k2) {
        u32x4 o; o.x = pk2(acc[2 * k2][0], acc[2 * k2][1]); o.y = pk2(acc[2 * k2][2], acc[2 * k2][3]); o.z = pk2(acc[2 * k2 + 1][0], acc[2 * k2 + 1][1]); o.w = pk2(acc[2 * k2 + 1][2], acc[2 * k2 + 1][3]);
        *(u32x4*)(dst + (pt * 16 + fr) * 128 + ((nt0 >> 1) + k2) * 32 + 8 * fq) = o;
    }
    __syncthreads();
}

__device__ __forceinline__ void phase5(const Params& p) {
    const bf16_t* __restrict__ CS = (const bf16_t*)(p.ws + WS_CS); bf16_t* __restrict__ PS = (bf16_t*)(p.ws + WS_PS); const float* __restrict__ DEC = (const float*)(p.ws + WS_DEC);
    const int tid_ = opaque_tid();
    for (int e8 = blockIdx.x * 512 + tid_; e8 < NB * 2 * 16 * 1024; e8 += gridDim.x * 512) {
        const int n8 = (e8 & 1023) * 8, hg = (e8 >> 10) & 15, bd = e8 >> 14;
        float s[8];
#pragma unroll
        for (int e = 0; e < 8; ++e) s[e] = 0.f;
#pragma unroll 1
        for (int s0 = 0; s0 < 33; s0 += 11) {
            u32x4 cv[11]; float dv[11];
#pragma unroll
            for (int k = 0; k < 11; ++k) {
                const int slot = s0 + k;
                cv[k] = *(const u32x4*)(CS + ((size_t)(bd * NSLOT + slot) * 16 + hg) * 8192 + n8); dv[k] = DEC[(bd * NSLOT + slot) * 16 + hg];
            }
#pragma unroll
            for (int k = 0; k < 11; ++k) {
                const int slot = s0 + k;
                if (slot >= 2) { u32x4 o; o.x = pk2(s[0], s[1]); o.y = pk2(s[2], s[3]); o.z = pk2(s[4], s[5]); o.w = pk2(s[6], s[7]); *(u32x4*)(PS + ((size_t)(bd * NSLOT + slot) * 16 + hg) * 8192 + n8) = o; }
                const float d = dv[k];
                s[0] = d * s[0] + bflo(cv[k].x); s[1] = d * s[1] + bfhi(cv[k].x); s[2] = d * s[2] + bflo(cv[k].y); s[3] = d * s[3] + bfhi(cv[k].y);
                s[4] = d * s[4] + bflo(cv[k].z); s[5] = d * s[5] + bfhi(cv[k].z); s[6] = d * s[6] + bflo(cv[k].w); s[7] = d * s[7] + bfhi(cv[k].w);
            }
        }
        { u32x4 o; o.x = pk2(s[0], s[1]); o.y = pk2(s[2], s[3]); o.z = pk2(s[4], s[5]); o.w = pk2(s[6], s[7]); *(u32x4*)(PS + ((size_t)(bd * NSLOT + 33) * 16 + hg) * 8192 + n8) = o; }
    }
}

__device__ __forceinline__ void s3_item(const Params& p, LAS unsigned char* lds, int item) {
    const bf16_t* XT = (const bf16_t*)(p.ws + WS_XT); const bf16_t* BCN = (const bf16_t*)(p.ws + WS_BCN); const bf16_t* PS = (const bf16_t*)(p.ws + WS_PS);
    const bf16_t* ZS = (const bf16_t*)(p.ws + WS_ZS); bf16_t* HRAW = (bf16_t*)(p.ws + WS_HRAW);
    const int tid = opaque_tid(), lane = tid & 63, w = tid >> 6, fr = lane & 15, fq = lane >> 4;
    const int g = item & 3, c = (item >> 2) & 31, b = item >> 7;
    const int row0 = b * SEQ + c * 128, s0 = c * 128, slot_f = 2 + c, slot_b = 2 + (31 - c);
    LAS unsigned char* Xl = lds;
    LAS unsigned char* Cl = lds + 65536;
    LAS unsigned char* Bl = lds + 98304;
    LAS float* tab = (LAS float*)(lds + 131072);
#pragma unroll
    for (int i = 0; i < 8; ++i) { const int idx = tid + 512 * i, r = idx >> 4, sl = idx & 15;
        *(LAS u32x4*)(Xl + r * 256 + ((sl ^ (r & 15)) << 4)) = *(const u32x4*)(XT + ((size_t)b * 1024 + g * 256 + r) * TOKP + s0 + sl * 8); }
#pragma unroll
    for (int i = 0; i < 4; ++i) { const int idx = tid + 512 * i, r = idx >> 4, sl = idx & 15;
        *(LAS u32x4*)(Bl + r * 256 + ((sl ^ (r & 15)) << 4)) = *(const u32x4*)(BCN + (size_t)(row0 + r) * 1024 + g * 128 + sl * 8);
        *(LAS u32x4*)(Cl + r * 256 + ((sl ^ (r & 15)) << 4)) = *(const u32x4*)(BCN + (size_t)(row0 + r) * 1024 + 512 + g * 128 + sl * 8); }
    u32x4 pv[4];
    auto pload = [&](int hl_) {
#pragma unroll
        for (int i = 0; i < 4; ++i) {
            const int idx = tid + 512 * i, dir = idx >> 10, r = (idx >> 4) & 63, sl = idx & 15;
            const int slot = dir ? slot_b : slot_f;
            pv[i] = *(const u32x4*)(PS + ((size_t)((b * 2 + dir) * NSLOT + slot) * 16 + g * 4 + hl_) * 8192 + r * 128 + sl * 8);
        }
    };
    pload(0);
    chunk_tables(p, tab, row0, g);
    __syncthreads();
    bf16x8 cf[4];
#pragma unroll
    for (int ks = 0; ks < 4; ++ks) cf[ks] = *(const LAS bf16x8*)(Cl + (w * 16 + fr) * 256 + (((ks * 4 + fq) ^ fr) << 4));
    f32x4 cb[8];
#pragma unroll
    for (int st = 0; st < 8; ++st) {
        cb[st] = (f32x4){0.f, 0.f, 0.f, 0.f};
#pragma unroll
        for (int ks = 0; ks < 4; ++ks) {
            const bf16x8 bf = *(const LAS bf16x8*)(Bl + (st * 16 + fr) * 256 + (((ks * 4 + fq) ^ fr) << 4));
            cb[st] = MFMA16(bf, cf[ks], cb[st]);
        }
    }
    __syncthreads();
    const int l = w * 16 + fr;
#pragma unroll 1
    for (int hl = 0; hl < 4; ++hl) {
        const int hg = g * 4 + hl;
#pragma unroll
        for (int i = 0; i < 4; ++i) {
            const int idx = tid + 512 * i, dir = idx >> 10, r = (idx >> 4) & 63, sl = idx & 15;
            *(LAS u32x4*)(Bl + dir * 16384 + r * 256 + ((sl ^ (r & 15)) << 4)) = pv[i];
        }
        __syncthreads();
        if (hl < 3) pload(hl + 1);
        u32x2 zv[4]; f32x4 ngv[4];
#pragma unroll
        for (int q = 0; q < 4; ++q) { zv[q] = *(const u32x2*)(ZS + ((size_t)row0 + l) * 1024 + hg * 64 + q * 16 + 4 * fq); ngv[q] = *(const f32x4*)(p.ssd_norm_g + hg * 64 + q * 16 + 4 * fq); }
        LAS float* tf = tab + (hl * 2) * 256; LAS float* tbk = tab + (hl * 2 + 1) * 256;
        const float cfl = tf[l], cbl = tbk[l], dsum = tf[128 + l] + tbk[128 + l], dsk = p.d_skip[hg];
        bf16x8 wf[4];
        int lq = l, fqw = fq; asm volatile("" : "+v"(lq), "+v"(fqw));
#pragma unroll
        for (int sb = 0; sb < 4; ++sb) {
            float wv[8];
#pragma unroll
            for (int half = 0; half < 2; ++half) {
                const int st = 2 * sb + half, sbase = st * 16 + 4 * fq;
                const f32x4 csf = *(const LAS f32x4*)(tf + sbase), dtf = *(const LAS f32x4*)(tf + 128 + sbase);
                const f32x4 csb = *(const LAS f32x4*)(tbk + sbase), dtb = *(const LAS f32x4*)(tbk + 128 + sbase);
#pragma unroll
                for (int j = 0; j < 4; ++j) {
                    const int s = st * 16 + 4 * fqw + j; const float cbv = cb[st][j];
                    const bool fw = s < lq;
                    const float arg = fw ? (cfl - csf[j]) : (cbl - csb[j]), dts = fw ? dtf[j] : dtb[j];
                    float v = cbv * __expf(arg) * dts;
                    if (s == lq) v = cbv * dsum + dsk;
                    wv[half * 4 + j] = v;
                }
            }
            U8 t; t.u.x = pk2(wv[0], wv[1]); t.u.y = pk2(wv[2], wv[3]); t.u.z = pk2(wv[4], wv[5]); t.u.w = pk2(wv[6], wv[7]);
            wf[sb] = t.h;
        }
        const float ef = __expf(cfl), eb = __expf(cbl);
        float sq = 0.f;
#pragma unroll 1
        for (int pt = 0; pt < 4; ++pt) {
            f32x4 y = (f32x4){0.f, 0.f, 0.f, 0.f}, t0 = y, t1 = y;
            const int xr = hl * 64 + pt * 16 + fr;
#pragma unroll
            for (int sb = 0; sb < 4; ++sb) {
                U8 xa;
                const u32x2 lo = *(const LAS u32x2*)(Xl + xr * 256 + (((4 * sb + (fq >> 1)) ^ fr) << 4) + (fq & 1) * 8);
                const u32x2 hi = *(const LAS u32x2*)(Xl + xr * 256 + (((4 * sb + 2 + (fq >> 1)) ^ fr) << 4) + (fq & 1) * 8);
                xa.u.x = lo.x; xa.u.y = lo.y; xa.u.z = hi.x; xa.u.w = hi.y;
                y = MFMA16(xa.h, wf[sb], y);
            }
#pragma unroll
            for (int ks = 0; ks < 4; ++ks) {
                const bf16x8 pa = *(const LAS bf16x8*)(Bl + (pt * 16 + fr) * 256 + (((ks * 4 + fq) ^ fr) << 4));
                const bf16x8 pb = *(const LAS bf16x8*)(Bl + 16384 + (pt * 16 + fr) * 256 + (((ks * 4 + fq) ^ fr) << 4));
                t0 = MFMA16(pa, cf[ks], t0); t1 = MFMA16(pb, cf[ks], t1);
            }
            y += ef * t0 + eb * t1;
            const size_t row = (size_t)row0 + l; const int col = hg * 64 + pt * 16 + 4 * fq;
            const u32x2 z = (pt == 0) ? zv[0] : (pt == 1) ? zv[1] : (pt == 2) ? zv[2] : zv[3];
            const f32x4 ng = (pt == 0) ? ngv[0] : (pt == 1) ? ngv[1] : (pt == 2) ? ngv[2] : ngv[3];
            const float v0 = y[0] * bflo(z.x), v1 = y[1] * bfhi(z.x), v2 = y[2] * bflo(z.y), v3 = y[3] * bfhi(z.y);
            sq += v0 * v0 + v1 * v1 + v2 * v2 + v3 * v3;
            u32x2 o; o.x = pk2(v0 * ng[0], v1 * ng[1]); o.y = pk2(v2 * ng[2], v3 * ng[3]);
            *(u32x2*)(HRAW + row * DM + 1024 + col) = o;
        }
        sq += __shfl_xor(sq, 16); sq += __shfl_xor(sq, 32);
        if (fq == 0) ((float*)(p.ws + WS_SSQS))[((size_t)row0 + l) * 16 + hg] = sq;
        __syncthreads();
    }
}

__device__ __forceinline__ void phase7(const Params& p) {
    bf16_t* HRAW = (bf16_t*)(p.ws + WS_HRAW);
    const int tid_ = opaque_tid(), lane = tid_ & 63, wid = tid_ >> 6;
    const int stride = gridDim.x * 8;
    for (int row0 = blockIdx.x * 8 + wid; row0 < NX; row0 += 4 * stride) {
        u32x4 v[4][4]; float ss[4][2];
#pragma unroll
        for (int r = 0; r < 4; ++r) {
            const int row = (row0 + r * stride < NX) ? row0 + r * stride : row0;
#pragma unroll
            for (int i = 0; i < 4; ++i) v[r][i] = *(const u32x4*)(HRAW + (size_t)row * DM + (i * 64 + lane) * 8);
        }
#pragma unroll
        for (int r = 0; r < 4; ++r) {
            ss[r][0] = 0.f; ss[r][1] = 0.f;
#pragma unroll
            for (int i = 0; i < 4; ++i)
#pragma unroll
                for (int e = 0; e < 4; ++e) { const float a = bflo(v[r][i][e]), c = bfhi(v[r][i][e]); ss[r][i >> 1] += a * a + c * c; }
            ss[r][0] = wave_sum(ss[r][0]); ss[r][1] = wave_sum(ss[r][1]);
        }
#pragma unroll
        for (int r = 0; r < 4; ++r) {
            const int row = row0 + r * stride;
            if (row < NX) {
                const float r0 = rsqrtf(ss[r][0] * (1.0f / 1024.0f) + EPS), r1 = rsqrtf(ss[r][1] * (1.0f / 1024.0f) + EPS);
#pragma unroll
                for (int i = 0; i < 4; ++i) {
                    const int k = (i * 64 + lane) * 8; const float rs = (i < 2) ? r0 : r1;
                    const float* gp = (i < 2) ? p.att_norm_g + k : p.ssd_norm_g + (k - 1024);
                    const f32x4 g0 = *(const f32x4*)gp, g1 = *(const f32x4*)(gp + 4);
                    u32x4 o;
                    o.x = pk2(bflo(v[r][i].x) * rs * g0[0], bfhi(v[r][i].x) * rs * g0[1]); o.y = pk2(bflo(v[r][i].y) * rs * g0[2], bfhi(v[r][i].y) * rs * g0[3]);
                    o.z = pk2(bflo(v[r][i].z) * rs * g1[0], bfhi(v[r][i].z) * rs * g1[1]); o.w = pk2(bflo(v[r][i].w) * rs * g1[2], bfhi(v[r][i].w) * rs * g1[3]);
                    *(u32x4*)(HRAW + (size_t)row * DM + k) = o;
                }
            }
        }
    }
}

__device__ __forceinline__ void phase9(const Params& p) {
    const bf16_t* RB = (const bf16_t*)(p.ws + WS_RB);
    const int tid_ = opaque_tid(), lane = tid_ & 63, wid = tid_ >> 6;
    const int stride = gridDim.x * 8;
    for (int row0 = blockIdx.x * 8 + wid; row0 < NX; row0 += 4 * stride) {
        u32x4 v[4][4]; float ss[4];
#pragma unroll
        for (int r = 0; r < 4; ++r) {
            const int row = (row0 + r * stride < NX) ? row0 + r * stride : row0;
#pragma unroll
            for (int i = 0; i < 4; ++i) v[r][i] = *(const u32x4*)(RB + (size_t)row * DM + (i * 64 + lane) * 8);
        }
#pragma unroll
        for (int r = 0; r < 4; ++r) {
            ss[r] = 0.f;
#pragma unroll
            for (int i = 0; i < 4; ++i)
#pragma unroll
                for (int e = 0; e < 4; ++e) { const float a = bflo(v[r][i][e]), c = bfhi(v[r][i][e]); ss[r] += a * a + c * c; }
            ss[r] = wave_sum(ss[r]);
        }
#pragma unroll
        for (int r = 0; r < 4; ++r) {
            const int row = row0 + r * stride;
            if (row < NX) {
                const float rstd = rsqrtf(ss[r] * (1.0f / DM) + EPS);
#pragma unroll
                for (int i = 0; i < 4; ++i) {
                    const int k = (i * 64 + lane) * 8;
                    const f32x4 g0 = *(const f32x4*)(p.final_norm_g + k), g1 = *(const f32x4*)(p.final_norm_g + k + 4);
                    f32x4 o0, o1;
                    o0[0] = bflo(v[r][i].x) * rstd * g0[0]; o0[1] = bfhi(v[r][i].x) * rstd * g0[1]; o0[2] = bflo(v[r][i].y) * rstd * g0[2]; o0[3] = bfhi(v[r][i].y) * rstd * g0[3];
                    o1[0] = bflo(v[r][i].z) * rstd * g1[0]; o1[1] = bfhi(v[r][i].z) * rstd * g1[1]; o1[2] = bflo(v[r][i].w) * rstd * g1[2]; o1[3] = bfhi(v[r][i].w) * rstd * g1[3];
                    *(f32x4*)(p.out + (size_t)row * DM + k) = o0; *(f32x4*)(p.out + (size_t)row * DM + k + 4) = o1;
                }
            }
        }
    }
}

#define XB_TMO      128
#define XB_XCNT(j)  (256  + 64 * (j))
#define XB_XSUB(j)  (1280 + 64 * (j))
#define XB_XGEN(j)  (2304 + 64 * (j))
#define XB_TOP      3328
#define XB_TOPGEN   3392
#define XCD_BAR_WORDS 3456
#define XB_SPIN_CAP (1u << 22)
__device__ __forceinline__ unsigned xb_ld(unsigned* p)              { return __hip_atomic_load(p, __ATOMIC_RELAXED, __HIP_MEMORY_SCOPE_AGENT); }
__device__ __forceinline__ unsigned xb_add(unsigned* p, unsigned v) { return __hip_atomic_fetch_add(p, v, __ATOMIC_RELAXED, __HIP_MEMORY_SCOPE_AGENT); }
__device__ __forceinline__ unsigned xb_xcc_id() { return (unsigned)__builtin_amdgcn_s_getreg((3 << 11) | 20) & 0xFu; }
#define XB_SPIN(cond, bar) do { unsigned _sp = 0; while (cond) { __builtin_amdgcn_s_sleep(1); \
    if ((++_sp & 255u) == 0u) { if (xb_ld(&(bar)[XB_TMO])) break; if (_sp > XB_SPIN_CAP) { atomicAdd(&(bar)[XB_TMO], 1u); break; } } } } while (0)
struct XcdBarrier { unsigned* bar; unsigned x; volatile LAS unsigned* st; };
__device__ __forceinline__ XcdBarrier xcd_barrier_post(unsigned* bar, volatile LAS unsigned* st) {
    XcdBarrier b; b.bar = bar; b.x = xb_xcc_id(); b.st = st;
    if (threadIdx.x == 0) (void)xb_add(&bar[XB_XCNT(b.x)], 1u);
    return b;
}
__device__ __forceinline__ void xcd_barrier_complete(unsigned* bar, unsigned x, unsigned& nloc, unsigned& nx) {
    const unsigned G = gridDim.x * gridDim.y * gridDim.z;
    unsigned sum, cnt, mine, sp = 0u;
    for (;;) {
        sum = 0u; cnt = 0u; mine = 0u;
#pragma unroll
        for (unsigned j = 0; j < 16; ++j) { const unsigned c = xb_ld(&bar[XB_XCNT(j)]); sum += c; cnt += (c > 0u) ? 1u : 0u; mine = (j == x) ? c : mine; }
        if (sum == G) break;
        __builtin_amdgcn_s_sleep(1);
        if ((++sp & 255u) == 0u) { if (xb_ld(&bar[XB_TMO])) break; if (sp > XB_SPIN_CAP) { atomicAdd(&bar[XB_TMO], 1u); break; } }
    }
    nloc = mine > 0u ? mine : 1u; nx = cnt > 0u ? cnt : 1u;
}
__device__ __forceinline__ void xcd_barrier(const XcdBarrier& b) {
    asm volatile("s_waitcnt vmcnt(0)" ::: "memory");
    __syncthreads();
    if (threadIdx.x == 0) {
        unsigned* bar = b.bar;
        __builtin_amdgcn_s_waitcnt(0);
        unsigned nloc = b.st[0], nx = b.st[1];
        if (nloc == 0u) { xcd_barrier_complete(bar, b.x, nloc, nx); b.st[0] = nloc; b.st[1] = nx; }
        const unsigned old = xb_add(&bar[XB_XSUB(b.x)], 1u);
        const unsigned gen = old / nloc;
        if (old + 1u == (gen + 1u) * nloc) {
            __builtin_amdgcn_fence(__ATOMIC_RELEASE, "agent");
            asm volatile("s_waitcnt vmcnt(0)" ::: "memory");
            const unsigned og = xb_add(&bar[XB_TOP], 1u);
            const unsigned tg = og / nx;
            if (og + 1u == (tg + 1u) * nx) xb_add(&bar[XB_TOPGEN], 1u);
            else XB_SPIN(xb_ld(&bar[XB_TOPGEN]) == tg, bar);
            __builtin_amdgcn_fence(__ATOMIC_ACQUIRE, "agent");
            xb_add(&bar[XB_XGEN(b.x)], 1u);
            asm volatile("s_waitcnt vmcnt(0)" ::: "memory");
        } else {
            XB_SPIN(xb_ld(&bar[XB_XGEN(b.x)]) == gen, bar);
            __builtin_amdgcn_fence(__ATOMIC_ACQUIRE, "agent");
            asm volatile("s_waitcnt vmcnt(0)" ::: "memory");
        }
    }
    __syncthreads();
}

constexpr int N_PHASES = 10;
__global__ void __launch_bounds__(512, 2) hybrid_fwd(Params p) {
    extern __shared__ __attribute__((aligned(16))) unsigned char shm[];
    LAS unsigned char* lds = (LAS unsigned char*)shm;
    cg::grid_group grid = cg::this_grid();
    volatile LAS unsigned* xst = (volatile LAS unsigned*)(lds + LDS_BYTES - 16);
    if (threadIdx.x == 0) { xst[0] = 0u; xst[1] = 0u; }
    __syncthreads();
    const XcdBarrier xb = xcd_barrier_post((unsigned*)(p.ws + WS_BAR), xst);
    if (p.ph_hi > 1000) grid.sync();
#ifdef ONLY_PHASE
#define RUN_PHASE(n) if ((n) == ONLY_PHASE && p.ph_lo <= (n) && (n) < p.ph_hi)
#elif defined(DBG_REPEAT)
#define RUN_PHASE(n) for (int rep_ = 0; rep_ < (((n) == DBG_REPEAT) ? 2 : 1); ++rep_, ((rep_ < (((n) == DBG_REPEAT) ? 2 : 1)) ? xcd_barrier(xb) : (void)0)) if (p.ph_lo <= (n) && (n) < p.ph_hi)
#else
#define RUN_PHASE(n) if (p.ph_lo <= (n) && (n) < p.ph_hi)
#endif
#define SEAM(n) if (p.ph_lo < (n) && (n) < p.ph_hi) xcd_barrier(xb)
#ifdef DBG_XSYNC
    for (int i_ = 0; i_ < DBG_XSYNC; ++i_) xcd_barrier(xb);
#endif
    RUN_PHASE(0) phase0(p, lds);
    SEAM(1);
    RUN_PHASE(1) phase1(p);
    SEAM(2);
    RUN_PHASE(2) {
        phase2_dt(p);
        pg8::Gemm g; g.A = (const bf16_t*)(p.ws + WS_XN); g.Bt = (const bf16_t*)(p.ws + WS_WINT); g.M = NR; g.N = NMAIN; g.K = DM;
        pg8::OrderIn S; S.G = (int)gridDim.x; S.c = (int)blockIdx.x;
        EpiIn E; E.ws = p.ws; E.ropeC = (const float*)(p.ws + WS_ROPEC); E.ropeS = (const float*)(p.ws + WS_ROPES);
        pg8::gemm_phase<EpiIn, pg8::OrderIn>(lds, g, S, E);
    }
    SEAM(3);
    RUN_PHASE(3) {
        constexpr int N_ATT = NB * 32 * 8;
        attn_phase(p, lds, N_ATT);
        conv_phase(p, lds);
#ifdef DBG_CONV2
        conv_phase(p, lds);
#endif
    }
    SEAM(4);
    RUN_PHASE(4) {
        for (int it = blockIdx.x; it < NB * 32 * 4; it += gridDim.x) { const int g = it & 3, c = (it >> 2) & 31, b = it >> 7; s1_item(p, lds, ((b * NSLOT + 2 + c) << 2) | g); }
        for (int sub = blockIdx.x; sub < 256; sub += gridDim.x) s1_ctx_item(p, lds, sub);
    }
    SEAM(5);
    RUN_PHASE(5) phase5(p);
    SEAM(6);
    RUN_PHASE(6) { for (int item = blockIdx.x; item < NB * 32 * 4; item += gridDim.x) s3_item(p, lds, item); }
    SEAM(8);
    RUN_PHASE(8) {
        pg8::Gemm g; g.A = (const bf16_t*)(p.ws + WS_HRAW); g.Bt = (const bf16_t*)(p.ws + WS_WOUTT); g.M = NX; g.N = DM; g.K = DM;
        pg8::StaticOrder S; S.init(NX, DM, (int)gridDim.x, (int)blockIdx.x);
        {
            const int tid = opaque_tid();
            const float* SA = (const float*)(p.ws + WS_SSQA); const float* SY = (const float*)(p.ws + WS_SSQS);
            pg8::Unit uu;
            for (int i = 0; i < MAX_OUT_UNITS && S.next(i, uu); ++i) {
                if (tid < 256) {
                    const size_t row = (size_t)uu.pm * 256 + tid;
                    float sa = 0.f, sy = 0.f;
#pragma unroll
                    for (int q = 0; q < 4; ++q) { const f32x4 a4 = *(const f32x4*)(SA + row * 16 + q * 4), y4 = *(const f32x4*)(SY + row * 16 + q * 4); sa += (a4[0] + a4[1]) + (a4[2] + a4[3]); sy += (y4[0] + y4[1]) + (y4[2] + y4[3]); }
                    const float ra = rsqrtf(sa * (1.0f / 1024.0f) + EPS), ry = rsqrtf(sy * (1.0f / 1024.0f) + EPS);
                    ((LAS float*)(lds + RAT_OFF))[i * 256 + tid] = ra / ry; ((LAS float*)(lds + RSY_OFF))[i * 256 + tid] = ry;
                }
            }
            __syncthreads();
        }
        EpiOut E; E.x = p.x; E.mod = (const float*)(p.ws + WS_MOD); E.rb = (bf16_t*)(p.ws + WS_RB); E.lds = lds;
        pg8::gemm_phase<EpiOut, pg8::StaticOrder>(lds, g, S, E);
    }
    SEAM(9);
    RUN_PHASE(9) phase9(p);
#ifdef DBG_STOP
    RUN_PHASE(10) {
        const int tid_ = opaque_tid(), lane = tid_ & 63, wid = tid_ >> 6;
        for (int row = blockIdx.x * 8 + wid; row < NX; row += gridDim.x * 8) {
            const bf16_t* src = (const bf16_t*)(p.ws + DBG_DUMP) + (size_t)row * DM;
            for (int i = lane; i < DM; i += 64) { float v = __uint_as_float((unsigned)src[i] << 16); if (!(fabsf(v) < 1e30f)) v = 12345.0f; p.out[(size_t)row * DM + i] = v; }
        }
    }
#endif
}

extern "C" void kernel_launch(void* const* d_in, const int* in_sizes, int n_in, void* d_out, int out_size, void* d_ws, size_t ws_size, hipStream_t stream) {
    static int grid = 0;
    if (grid == 0) {
        if (n_in != 20 || in_sizes[0] != NX * DM || out_size != NX * DM || ws_size < WS_END) {
            fprintf(stderr, "kernel_launch: unexpected shapes (n_in %d, in0 %d, out %d, ws %zu need %zu)\n", n_in, n_in > 0 ? in_sizes[0] : -1, out_size, ws_size, (size_t)WS_END); grid = -1; return; }
        int dev = 0, cus = 0, per_cu = 0;
        hipGetDevice(&dev); hipDeviceGetAttribute(&cus, hipDeviceAttributeMultiprocessorCount, dev);
        if (hipFuncSetAttribute((const void*)hybrid_fwd, hipFuncAttributeMaxDynamicSharedMemorySize, LDS_BYTES) != hipSuccess) { fprintf(stderr, "kernel_launch: hipFuncSetAttribute failed\n"); grid = -1; return; }
        if (hipOccupancyMaxActiveBlocksPerMultiprocessor(&per_cu, (const void*)hybrid_fwd, 512, LDS_BYTES) != hipSuccess || per_cu < 1) { fprintf(stderr, "kernel_launch: occupancy query says %d\n", per_cu); per_cu = 1; }
        (void)hipGetLastError();
        grid = cus * 1;
    }
    if (grid < 0) return;
    Params p{};
    const float** pp = (const float**)&p;
    for (int i = 0; i < 20; ++i) pp[i] = (const float*)d_in[i];
    p.out = (float*)d_out; p.ws = (unsigned char*)d_ws;
    if (hipMemsetAsync((char*)d_ws + WS_BAR, 0, XCD_BAR_WORDS * 4, stream) != hipSuccess) { fprintf(stderr, "kernel_launch: memset of barrier words failed\n"); return; }
#if MK_LAUNCHES == 1
    p.ph_lo = 0; p.ph_hi = N_PHASES;
    void* args[] = {&p};
    hipError_t e = hipLaunchCooperativeKernel((const void*)hybrid_fwd, dim3(grid), dim3(512), args, LDS_BYTES, stream);
    if (e != hipSuccess) fprintf(stderr, "cooperative launch failed: %s (grid %d)\n", hipGetErrorString(e), grid);
#else
#ifdef DBG_STOP
    for (int ph = 0; ph <= DBG_STOP; ++ph) { p.ph_lo = ph; p.ph_hi = ph + 1; hipLaunchKernelGGL(hybrid_fwd, dim3(grid), dim3(512), LDS_BYTES, stream, p); }
    p.ph_lo = 10; p.ph_hi = 11; hipLaunchKernelGGL(hybrid_fwd, dim3(grid), dim3(512), LDS_BYTES, stream, p);
#else
    for (int ph = 0; ph < N_PHASES; ++ph) { p.ph_lo = ph; p.ph_hi = ph + 1; hipLaunchKernelGGL(hybrid_fwd, dim3(grid), dim3(512), LDS_BYTES, stream, p); }
#endif
#endif
}
```

```cpp
#include <hip/hip_runtime.h>
#include <hip/hip_cooperative_groups.h>
#include <cstdio>
namespace cg = cooperative_groups;

#ifndef MK_LAUNCHES
#define MK_LAUNCHES 1
#endif

#define DBG_W(x) (x)
#define LAS __attribute__((address_space(3)))
typedef unsigned short bf16_t;
typedef short bf16x8 __attribute__((ext_vector_type(8)));
typedef float f32x4 __attribute__((ext_vector_type(4)));
typedef unsigned u32x4 __attribute__((ext_vector_type(4)));
typedef unsigned u32x2 __attribute__((ext_vector_type(2)));

constexpr int DM = 2048, NB = 4, SEQ = 4096, NCTX = 256;
constexpr int NX = NB * SEQ;
constexpr int NR = NX + NB * NCTX;
constexpr int NIN = 5664, NMAIN = 5632;
constexpr int TOKP = SEQ + NCTX;
constexpr int NSLOT = 34;
constexpr float QSCALE = 0.125f * 1.4426950408889634f;
constexpr float LOG2E = 1.4426950408889634f;
constexpr float EPS = 1e-6f;
constexpr int LDS_BYTES = 147456;

constexpr size_t al256(size_t x) { return (x + 255) & ~(size_t)255; }
constexpr size_t WS_MOD = 0;
constexpr size_t WS_ROPEC = al256(WS_MOD + 5 * 6144 * 4);
constexpr size_t WS_ROPES = al256(WS_ROPEC + 64 * 16 * 4);
constexpr size_t WS_DEC = al256(WS_ROPES + 64 * 16 * 4);
constexpr size_t WS_WINT = al256(WS_DEC + 4 * 2 * NSLOT * 16 * 4);
constexpr size_t WS_WDTT = al256(WS_WINT + (size_t)NMAIN * DM * 2);
constexpr size_t WS_WOUTT = al256(WS_WDTT + 32 * DM * 2);
constexpr size_t WS_XN = al256(WS_WOUTT + (size_t)DM * DM * 2);
constexpr size_t WS_CS = WS_XN;
constexpr size_t WS_QB = al256(WS_XN + (size_t)NR * DM * 2);
constexpr size_t WS_RB = WS_QB;
constexpr size_t WS_KB = al256(WS_QB + (size_t)NX * 1024 * 2);
constexpr size_t WS_VT = al256(WS_KB + (size_t)NR * 256 * 2);
constexpr size_t WS_GS = al256(WS_VT + (size_t)NB * 4 * 64 * TOKP * 2);
constexpr size_t WS_ZS = al256(WS_GS + (size_t)NX * 1024 * 2);
constexpr size_t WS_XBC = al256(WS_ZS + (size_t)NX * 1024 * 2);
constexpr size_t WS_PS = WS_XBC;
constexpr size_t WS_DT = al256(WS_XBC + (size_t)NR * DM * 2);
constexpr size_t WS_XT = al256(WS_DT + (size_t)NR * 32 * 4);
constexpr size_t WS_BT = al256(WS_XT + (size_t)NB * 1024 * TOKP * 2);
constexpr size_t WS_BCN = al256(WS_BT + (size_t)NB * 512 * TOKP * 2);
constexpr size_t WS_HRAW = al256(WS_BCN + (size_t)NR * 1024 * 2);
constexpr size_t WS_BAR = al256(WS_HRAW + (size_t)NX * DM * 2);
constexpr size_t WS_SSQA = al256(WS_BAR + 3456 * 4);
constexpr size_t WS_SSQS = al256(WS_SSQA + (size_t)NX * 16 * 4);
constexpr size_t WS_END = al256(WS_SSQS + (size_t)NX * 16 * 4);
static_assert((size_t)NB * 2 * NSLOT * 16 * 8192 * 2 <= (size_t)NR * DM * 2, "CS/PS alias size");
static_assert(WS_QB + (size_t)NX * DM * 2 <= WS_ZS, "RB alias must end before ZS (read by phase 6)");

struct Params {
    const float *x, *c, *ctx, *c_ctx, *w_mod, *b_mod, *norm_g, *w_in, *conv_w, *conv_b, *a_log_f, *a_log_b, *dt_bias_f, *dt_bias_b, *d_skip,
        *att_norm_g, *ssd_norm_g, *sink, *w_out, *final_norm_g;
    float* out; unsigned char* ws; int ph_lo, ph_hi;
};

typedef float f32x2 __attribute__((ext_vector_type(2)));
typedef __bf16 bf16x2_t __attribute__((ext_vector_type(2)));
__device__ __forceinline__ unsigned pk2(float lo, float hi) { const f32x2 v = {lo, hi}; const bf16x2_t r = __builtin_convertvector(v, bf16x2_t); return __builtin_bit_cast(unsigned, r); }
__device__ __forceinline__ float bflo(unsigned u) { return __uint_as_float(u << 16); }
__device__ __forceinline__ float bfhi(unsigned u) { return __uint_as_float(u & 0xffff0000u); }
__device__ __forceinline__ float siluf(float v) { return v * __builtin_amdgcn_rcpf(1.0f + __expf(-v)); }
__device__ __forceinline__ float wave_sum(float v) {
#pragma unroll
    for (int o = 32; o >= 1; o >>= 1) v += __shfl_xor(v, o);
    return v;
}
__device__ __forceinline__ int opaque_tid() { int t = threadIdx.x; asm volatile("" : "+v"(t)); return t; }
#define MFMA16(a, b, c) __builtin_amdgcn_mfma_f32_16x16x32_bf16((a), (b), (c), 0, 0, 0)
union U8 { u32x4 u; bf16x8 h; };

namespace pg8 {
constexpr int BM = 256, BK = 64, HALF = 128, HTB = HALF * BK * 2, STAGE_BYTES = 8 * HTB, NXCD = 8, WGM = 8;
__device__ __forceinline__ int lds_byte(int r, int c) { const int st = (r >> 4) * 2 + (c >> 5), rr = r & 15, cc = c & 31, ob = rr * 64 + cc * 2; return st * 1024 + (ob ^ (((ob >> 9) & 1) << 5)); }
__device__ __forceinline__ void stage_rc(int b, int& R, int& C) { const int st = b / 1024, sb = b % 1024, swz = sb ^ (((sb >> 9) & 1) << 5); R = (st >> 1) * 16 + swz / 64; C = (st & 1) * 32 + (swz % 64) / 2; }
__device__ __forceinline__ int perm32(int rho) { const int n = rho >> 4, i = rho & 15; return 8 * (i >> 2) + 4 * n + (i & 3); }
struct Unit { int pm, pn; };
struct Gemm { const bf16_t* A; const bf16_t* Bt; int M, N, K; };
__device__ __forceinline__ void static_map(int wgid, int nM, int nN, Unit& u, int WGM = 8) {
    const int nwg = nM * nN;
    { const int q = nwg / NXCD, r = nwg % NXCD, xcd = wgid % NXCD, off = wgid / NXCD; wgid = (xcd < r ? xcd * (q + 1) : r * (q + 1) + (xcd - r) * q) + off; }
    const int nig = WGM * nN, gid = wgid / nig, fm = gid * WGM, gsz = (nM - fm) < WGM ? (nM - fm) : WGM;
    u.pm = fm + ((wgid % nig) % gsz); u.pn = (wgid % nig) / gsz;
}
struct StaticOrder {
    int nM, nN, nwg, G, c;
    __device__ void init(int M, int N, int G_, int c_) { nM = M / BM; nN = N / BM; nwg = nM * nN; G = G_; c = c_; }
    __device__ bool next(int i, Unit& u) const { const long L = (long)i * G + c; if (L >= nwg) return false; static_map((int)L, nM, nN, u, 4); return true; }
};
struct OrderIn {
    int G, c;
    __device__ bool next(int i, Unit& u) const {
        const long L = (long)i * G + c; if (L >= 1448) return false;
        if (L < 1408) { static_map((int)L, 64, 22, u, 4); }
        else { const int e = (int)L - 1408, j = e % 10; u.pm = 64 + e / 10; u.pn = (j == 0) ? 4 : (j == 1) ? 5 : 12 + j; }
        return true;
    }
};

template <class Epi, class Sched>
__device__ __forceinline__ void gemm_phase(LAS unsigned char* lds, const Gemm g, const Sched& S, const Epi& E) {
    const int tid = opaque_tid(), wid = __builtin_amdgcn_readfirstlane(tid >> 6), lane = tid & 63, wr = wid >> 2, wc = wid & 3, fr = lane & 15, fq = lane >> 4;
    const int K = g.K, nt = K / BK;
    unsigned voffA[2], voffB[2];
#pragma unroll
    for (int i = 0; i < 2; ++i) { int R, C; stage_rc(tid * 16 + i * 8192, R, C); const int Rb = Epi::PERM ? ((R & ~31) + perm32(R & 31)) : R;
        voffA[i] = (unsigned)(R * K + C) * 2u; voffB[i] = (unsigned)(Rb * K + C) * 2u; }
    const size_t kstep = (size_t)(BK * 2);
    const size_t hstep = (size_t)HALF * K * 2;
    const size_t tstep = 2 * hstep;
    const unsigned ldsw = (unsigned)wid * 1024u;
    const int aoff = lds_byte(wr * 64 + fr, fq * 8), boff = lds_byte(wc * 32 + fr, fq * 8);
#define PG8_SA(b, h) (((b) * 2 + (h)) * HTB)
#define PG8_SB(b, h) ((4 + (b) * 2 + (h)) * HTB)
#define PG8_STAGE(bufoff, gbase, voff) do { _Pragma("unroll") for (int _i = 0; _i < 2; ++_i) \
        __builtin_amdgcn_global_load_lds((const unsigned*)((const char*)(gbase) + (voff)[_i]), (LAS unsigned*)(lds + (bufoff) + ldsw + _i * 8192), 16, 0, 0); } while (0)
#define PG8_LDA(dst, b, h) do { _Pragma("unroll") for (int m = 0; m < 4; ++m) _Pragma("unroll") for (int k = 0; k < 2; ++k) dst[m][k] = *(const LAS bf16x8*)(lds + PG8_SA(b, h) + aoff + m * 2048 + k * 1024); } while (0)
#define PG8_LDB(dst, b, h) do { _Pragma("unroll") for (int n = 0; n < 2; ++n) _Pragma("unroll") for (int k = 0; k < 2; ++k) dst[n][k] = *(const LAS bf16x8*)(lds + PG8_SB(b, h) + boff + n * 2048 + k * 1024); } while (0)
#define PG8_MMA(ai, bj, At, Bt) do { __builtin_amdgcn_s_setprio(1); _Pragma("unroll") for (int m = 0; m < 4; ++m) _Pragma("unroll") for (int n = 0; n < 2; ++n) _Pragma("unroll") for (int k = 0; k < 2; ++k) \
        acc[ai][bj][m][n] = __builtin_amdgcn_mfma_f32_16x16x32_bf16(Bt[n][k], At[m][k], acc[ai][bj][m][n], 0, 0, 0); __builtin_amdgcn_s_setprio(0); } while (0)
#define PG8_WAIT_V(n) asm volatile("s_waitcnt vmcnt(" #n ")" ::: "memory")
#define PG8_WAIT_L(n) asm volatile("s_waitcnt lgkmcnt(" #n ")" ::: "memory")
#define PG8_BAR __builtin_amdgcn_s_barrier()
#define PG8_SCHED __builtin_amdgcn_sched_barrier(0)
    Unit cur, nxt; int ui = 0;
    if (!S.next(0, cur)) return;
    f32x4 acc[2][2][4][2];
#pragma unroll
    for (int a = 0; a < 2; ++a)
#pragma unroll
        for (int b = 0; b < 2; ++b)
#pragma unroll
            for (int m = 0; m < 4; ++m)
#pragma unroll
                for (int n = 0; n < 2; ++n) acc[a][b][m][n] = (f32x4){0.f, 0.f, 0.f, 0.f};
    bf16x8 At[4][2], B0[2][2], B1[2][2];
    const char* cA = (const char*)g.A + (size_t)cur.pm * tstep; const char* cB = (const char*)g.Bt + (size_t)cur.pn * tstep;
    PG8_STAGE(PG8_SB(0, 0), cB, voffB); PG8_STAGE(PG8_SA(0, 0), cA, voffA); PG8_STAGE(PG8_SB(0, 1), cB + hstep, voffB); PG8_STAGE(PG8_SA(0, 1), cA + hstep, voffA);
    if (wr == 1) PG8_BAR;
    PG8_WAIT_V(4); PG8_BAR;
    PG8_STAGE(PG8_SB(1, 0), cB + kstep, voffB); PG8_STAGE(PG8_SA(1, 0), cA + kstep, voffA); PG8_STAGE(PG8_SB(1, 1), cB + hstep + kstep, voffB);
    PG8_WAIT_V(6); PG8_BAR;
    for (;;) {
        const bool has_next = S.next(ui + 1, nxt);
        const char* nA = has_next ? (const char*)g.A + (size_t)nxt.pm * tstep : cA; const char* nB = has_next ? (const char*)g.Bt + (size_t)nxt.pn * tstep : cB;
        for (int t = 0; t < nt; t += 2) {
            if (Epi::MIDK && t == nt / 2) E.midk(acc, ui, wr, fr);
            const bool last = (t == nt - 2);
            const char* a1 = cA + (size_t)(t + 1) * kstep;
            const char* a2 = last ? nA : cA + (size_t)(t + 2) * kstep; const char* b2 = last ? nB : cB + (size_t)(t + 2) * kstep;
            const char* a3 = a2 + kstep; const char* b3 = b2 + kstep;
            PG8_LDB(B0, 0, 0); PG8_SCHED; PG8_LDA(At, 0, 0); PG8_STAGE(PG8_SA(1, 1), a1 + hstep, voffA);
            PG8_WAIT_L(8); PG8_BAR; PG8_WAIT_L(0); PG8_MMA(0, 0, At, B0); PG8_BAR; PG8_SCHED;
            PG8_LDB(B1, 0, 1); PG8_STAGE(PG8_SB(0, 0), b2, voffB);
            PG8_BAR; PG8_WAIT_L(0); PG8_MMA(0, 1, At, B1); PG8_BAR;
            PG8_LDA(At, 0, 1); PG8_STAGE(PG8_SA(0, 0), a2, voffA);
            PG8_BAR; PG8_WAIT_L(0); PG8_MMA(1, 0, At, B0); PG8_BAR; PG8_SCHED;
            PG8_STAGE(PG8_SB(0, 1), b2 + hstep, voffB);
            PG8_WAIT_V(6); PG8_BAR; PG8_MMA(1, 1, At, B1); PG8_BAR;
            PG8_LDB(B0, 1, 0); PG8_SCHED; PG8_LDA(At, 1, 0); PG8_STAGE(PG8_SA(0, 1), a2 + hstep, voffA);
            PG8_WAIT_L(8); PG8_BAR; PG8_WAIT_L(0); PG8_MMA(0, 0, At, B0); PG8_BAR; PG8_SCHED;
            PG8_LDB(B1, 1, 1); PG8_STAGE(PG8_SB(1, 0), b3, voffB);
            PG8_BAR; PG8_WAIT_L(0); PG8_MMA(0, 1, At, B1); PG8_BAR;
            PG8_LDA(At, 1, 1); PG8_STAGE(PG8_SA(1, 0), a3, voffA);
            PG8_BAR; PG8_WAIT_L(0); PG8_MMA(1, 0, At, B0); PG8_BAR; PG8_SCHED;
            PG8_STAGE(PG8_SB(1, 1), b3 + hstep, voffB);
            PG8_WAIT_V(6); PG8_BAR; PG8_MMA(1, 1, At, B1); PG8_BAR;
        }
        E(acc, cur, ui, wr, wc, fr, fq);
        if (!has_next) break;
#pragma unroll
        for (int a = 0; a < 2; ++a)
#pragma unroll
            for (int b = 0; b < 2; ++b)
#pragma unroll
                for (int m = 0; m < 4; ++m)
#pragma unroll
                    for (int n = 0; n < 2; ++n) acc[a][b][m][n] = (f32x4){0.f, 0.f, 0.f, 0.f};
        cur = nxt; cA = nA; cB = nB; ++ui;
    }
    PG8_WAIT_V(0);
    if (wr == 0) PG8_BAR;
    PG8_BAR;
#undef PG8_SA
#undef PG8_SB
#undef PG8_STAGE
#undef PG8_LDA
#undef PG8_LDB
#undef PG8_MMA
#undef PG8_WAIT_V
#undef PG8_WAIT_L
#undef PG8_BAR
#undef PG8_SCHED
}
}

struct EpiIn {
    static constexpr bool PERM = true, MIDK = false;
    unsigned char* ws; const float *ropeC, *ropeS;
    __device__ __forceinline__ void midk(f32x4 (&)[2][2][4][2], int, int, int) const {}
    __device__ __forceinline__ void operator()(const f32x4 (&acc)[2][2][4][2], const pg8::Unit& u, int, int wr, int wc, int fr, int fq) const {
        asm volatile("" : "+v"(fr), "+v"(fq));
        const int pn = u.pn;
        const int rowb = u.pm * 256 + wr * 64 + fr;
        const int colw = wc * 32 + 8 * fq;
#ifndef EPI_NO_ROPE
        if (pn <= 4) {
            const bool isq = pn < 4, ctxrow = u.pm >= 64;
            bf16_t* base = (bf16_t*)(ws + (isq ? WS_QB : WS_KB)); const int ld = isq ? 1024 : 256, cbase = isq ? pn * 256 : 0;
            const float sc = isq ? QSCALE : 1.0f, sgn = (fq < 2) ? -1.0f : 1.0f;
#pragma unroll
            for (int ai = 0; ai < 2; ++ai)
#pragma unroll
                for (int m = 0; m < 4; ++m) { __builtin_amdgcn_sched_barrier(0);
                    const int row = rowb + ai * 128 + m * 16, s = row & 4095, pos = (wc & 1) ? (s & 63) : (s >> 6);
                    f32x4 c0 = *(const f32x4*)(ropeC + pos * 16 + 8 * (fq & 1)), c1 = *(const f32x4*)(ropeC + pos * 16 + 8 * (fq & 1) + 4);
                    f32x4 s0 = *(const f32x4*)(ropeS + pos * 16 + 8 * (fq & 1)), s1 = *(const f32x4*)(ropeS + pos * 16 + 8 * (fq & 1) + 4);
                    if (ctxrow) { c0 = c1 = (f32x4){1.f, 1.f, 1.f, 1.f}; s0 = s1 = (f32x4){0.f, 0.f, 0.f, 0.f}; }
#pragma unroll
                    for (int bj = 0; bj < 2; ++bj) {
                        const f32x4 v0 = acc[ai][bj][m][0], v1 = acc[ai][bj][m][1]; f32x4 p0, p1;
#pragma unroll
                        for (int j = 0; j < 4; ++j) { p0[j] = __shfl_xor(v0[j], 32); p1[j] = __shfl_xor(v1[j], 32); }
                        const f32x4 o0 = (v0 * c0 + sgn * p0 * s0) * sc, o1 = (v1 * c1 + sgn * p1 * s1) * sc;
                        u32x4 w; w.x = pk2(o0[0], o0[1]); w.y = pk2(o0[2], o0[3]); w.z = pk2(o1[0], o1[1]); w.w = pk2(o1[2], o1[3]);
                        *(u32x4*)(base + (size_t)row * ld + cbase + bj * 128 + colw) = w;
                        __builtin_amdgcn_sched_barrier(0);
                    }
                }
        } else
#endif
#ifndef EPI_NO_V
        if (pn == 5) {
            bf16_t* VT = (bf16_t*)(ws + WS_VT);
#pragma unroll
            for (int ai = 0; ai < 2; ++ai)
#pragma unroll
                for (int m = 0; m < 4; ++m) { __builtin_amdgcn_sched_barrier(0);
                    const int row = rowb + ai * 128 + m * 16;
                    int b, s; if (row < NX) { b = row >> 12; s = row & 4095; } else { b = (row - NX) >> 8; s = SEQ + ((row - NX) & 255); }
#pragma unroll
                    for (int bj = 0; bj < 2; ++bj)
#pragma unroll
                        for (int n = 0; n < 2; ++n)
#pragma unroll
                            for (int j = 0; j < 4; ++j) {
                                const int col = bj * 128 + colw + 4 * n + j;
                                VT[((size_t)(b * 4 + (col >> 6)) * 64 + (col & 63)) * TOKP + s] = (bf16_t)(pk2(acc[ai][bj][m][n][j], 0.f) & 0xffffu);
                            }
                }
        } else
#endif
        {
            const bool act = pn < 14;
            bf16_t* base = (bf16_t*)(ws + ((pn < 10) ? WS_GS : (pn < 14) ? WS_ZS : WS_XBC));
            const int ld = act ? 1024 : 2048, cbase = (pn < 10) ? (pn - 6) * 256 : (pn < 14) ? (pn - 10) * 256 : (pn - 14) * 256;
#pragma unroll
            for (int ai = 0; ai < 2; ++ai)
#pragma unroll
                for (int m = 0; m < 4; ++m) { __builtin_amdgcn_sched_barrier(0);
                    const int row = rowb + ai * 128 + m * 16;
#pragma unroll
                    for (int bj = 0; bj < 2; ++bj) {
                        f32x4 v0 = acc[ai][bj][m][0], v1 = acc[ai][bj][m][1];
                        if (act) {
#pragma unroll
                            for (int j = 0; j < 4; ++j) { v0[j] = siluf(v0[j]); v1[j] = siluf(v1[j]); }
                        }
                        u32x4 w; w.x = pk2(v0[0], v0[1]); w.y = pk2(v0[2], v0[3]); w.z = pk2(v1[0], v1[1]); w.w = pk2(v1[2], v1[3]);
                        *(u32x4*)(base + (size_t)row * ld + cbase + bj * 128 + colw) = w;
                        __builtin_amdgcn_sched_barrier(0);
                    }
                }
        }
    }
};
constexpr int RAT_OFF = 131072, RSY_OFF = 131072 + 6 * 256 * 4, MAX_OUT_UNITS = 6;
struct EpiOut {
    static constexpr bool PERM = true, MIDK = true;
    const float* x; const float* mod; bf16_t* rb; LAS unsigned char* lds;
    __device__ __forceinline__ void midk(f32x4 (&acc)[2][2][4][2], int ui, int wr, int fr) const {
        const LAS float* rat = (const LAS float*)(lds + RAT_OFF) + ui * 256 + wr * 64 + fr;
#pragma unroll
        for (int ai = 0; ai < 2; ++ai)
#pragma unroll
            for (int m = 0; m < 4; ++m) {
                const float r = rat[ai * 128 + m * 16];
#pragma unroll
                for (int bj = 0; bj < 2; ++bj)
#pragma unroll
                    for (int n = 0; n < 2; ++n) acc[ai][bj][m][n] *= r;
            }
    }
    __device__ __forceinline__ void operator()(const f32x4 (&acc)[2][2][4][2], const pg8::Unit& u, int ui, int wr, int wc, int fr, int fq) const {
        asm volatile("" : "+v"(fr), "+v"(fq));
        const int row0 = u.pm * 256 + wr * 64 + fr, col0 = u.pn * 256 + wc * 32 + 8 * fq;
        const int b = (u.pm * 256) >> 12;
        const LAS float* rsy = (const LAS float*)(lds + RSY_OFF) + ui * 256 + wr * 64 + fr;
        f32x4 gv[2][2];
#pragma unroll
        for (int bj = 0; bj < 2; ++bj)
#pragma unroll
            for (int n = 0; n < 2; ++n) gv[bj][n] = *(const f32x4*)(mod + b * 6144 + 4096 + col0 + bj * 128 + n * 4);
#pragma unroll
        for (int ai = 0; ai < 2; ++ai) {
            f32x4 xv[4][2][2];
#pragma unroll
            for (int m = 0; m < 4; ++m) {
                const size_t ro = (size_t)(row0 + ai * 128 + m * 16) * DM + col0;
#pragma unroll
                for (int bj = 0; bj < 2; ++bj) { xv[m][bj][0] = __builtin_nontemporal_load((const f32x4*)(x + ro + bj * 128)); xv[m][bj][1] = __builtin_nontemporal_load((const f32x4*)(x + ro + bj * 128 + 4)); }
            }
            __builtin_amdgcn_sched_barrier(0);
#pragma unroll
            for (int m = 0; m < 4; ++m) {
                const size_t ro = (size_t)(row0 + ai * 128 + m * 16) * DM + col0;
                const float ry = rsy[ai * 128 + m * 16];
#pragma unroll
                for (int bj = 0; bj < 2; ++bj) {
                    const f32x4 r0 = xv[m][bj][0] + gv[bj][0] * (ry * acc[ai][bj][m][0]), r1 = xv[m][bj][1] + gv[bj][1] * (ry * acc[ai][bj][m][1]);
                    u32x4 w; w.x = pk2(r0[0], r0[1]); w.y = pk2(r0[2], r0[3]); w.z = pk2(r1[0], r1[1]); w.w = pk2(r1[2], r1[3]);
                    *(u32x4*)(rb + ro + bj * 128) = w;
                }
            }
            __builtin_amdgcn_sched_barrier(0);
        }
    }
};

__device__ __forceinline__ void p0_mod_item(const Params& p, LAS unsigned char* lds, int item) {
    LAS float* sc = (LAS float*)lds;
    LAS float* red = (LAS float*)(lds + 5 * 2048 * 4);
    const int tid = opaque_tid(), c0 = item * 32;
    for (int idx = tid; idx < 5 * 2048; idx += 512) { const int b = idx >> 11, k = idx & 2047; const float v = (b < 4) ? p.c[b * 2048 + k] : p.c_ctx[k]; sc[idx] = siluf(v); }
    __syncthreads();
    const int rr = tid >> 3, pc = tid & 7;
    f32x4 a[5];
#pragma unroll
    for (int b = 0; b < 5; ++b) a[b] = (f32x4){0.f, 0.f, 0.f, 0.f};
    const float* wp = p.w_mod + (size_t)rr * 6144 + c0 + 4 * pc;
#pragma unroll 8
    for (int i = 0; i < 32; ++i) {
        const f32x4 w = __builtin_nontemporal_load((const f32x4*)(wp + (size_t)i * 64 * 6144));
        const int row = i * 64 + rr;
#pragma unroll
        for (int b = 0; b < 5; ++b) a[b] += sc[b * 2048 + row] * w;
    }
#pragma unroll
    for (int b = 0; b < 5; ++b)
#pragma unroll
        for (int j = 0; j < 4; ++j) red[(rr * 8 + pc) * 20 + b * 4 + j] = a[b][j];
    __syncthreads();
    if (tid < 160) {
        const int b = tid >> 5, col = tid & 31, pcc = col >> 2, j = col & 3; float s = 0.f;
        for (int r = 0; r < 64; ++r) s += red[(r * 8 + pcc) * 20 + b * 4 + j];
        ((float*)(p.ws + WS_MOD))[b * 6144 + c0 + col] = s + p.b_mod[c0 + col];
    }
    __syncthreads();
}
__device__ __forceinline__ void p0_transpose_item(LAS unsigned char* lds, const float* src, int ldn, int k0, int n0, bf16_t* dst) {
    LAS float* T = (LAS float*)lds;
    const int tid = opaque_tid();
    f32x4 v[4];
#pragma unroll
    for (int i = 0; i < 4; ++i) { const int idx = tid + 512 * i, kr = idx >> 5, q = idx & 31; v[i] = __builtin_nontemporal_load((const f32x4*)(src + (size_t)(k0 + kr) * ldn + n0 + 4 * q)); }
#pragma unroll
    for (int i = 0; i < 4; ++i) { const int idx = tid + 512 * i, kr = idx >> 5, q = idx & 31;
#pragma unroll
        for (int j = 0; j < 4; ++j) T[(4 * q + j) * 65 + kr] = v[i][j]; }
    __syncthreads();
#pragma unroll
    for (int i = 0; i < 2; ++i) {
        const int idx = tid + 512 * i, n = idx >> 3, ks = idx & 7;
        float f[8];
#pragma unroll
        for (int e = 0; e < 8; ++e) f[e] = T[n * 65 + ks * 8 + e];
        u32x4 w; w.x = pk2(f[0], f[1]); w.y = pk2(f[2], f[3]); w.z = pk2(f[4], f[5]); w.w = pk2(f[6], f[7]);
        *(u32x4*)(dst + (size_t)(n0 + n) * 2048 + k0 + ks * 8) = w;
    }
    __syncthreads();
}
__device__ __forceinline__ void phase0(const Params& p, LAS unsigned char* lds) {
    bf16_t* WINT = (bf16_t*)(p.ws + WS_WINT); bf16_t* WDTT = (bf16_t*)(p.ws + WS_WDTT); bf16_t* WOUTT = (bf16_t*)(p.ws + WS_WOUTT);
    const int tid = opaque_tid();
    constexpr int N_MOD = 192, N_TIN = 1408, N_TOUT = 512, N_TDT = 32, N_ROPE = 1;
    constexpr int TOTAL = N_MOD + N_TIN + N_TOUT + N_TDT + N_ROPE;
    for (int item = blockIdx.x; item < TOTAL; item += gridDim.x) {
        int it = item;
        if (it < N_MOD) { p0_mod_item(p, lds, it); continue; }
        it -= N_MOD;
        if (it < N_TIN) { p0_transpose_item(lds, p.w_in, NIN, (it & 31) * 64, (it >> 5) * 128, WINT); continue; }
        it -= N_TIN;
        if (it < N_TOUT) { p0_transpose_item(lds, p.w_out, DM, (it & 31) * 64, (it >> 5) * 128, WOUTT); continue; }
        it -= N_TOUT;
        if (it < N_TDT) {
            const int k0 = it * 64;
#pragma unroll
            for (int i = 0; i < 4; ++i) { const int idx = tid + 512 * i, n = idx & 31, kr = idx >> 5;
                WDTT[(size_t)n * 2048 + k0 + kr] = (bf16_t)(pk2(p.w_in[(size_t)(k0 + kr) * NIN + NMAIN + n], 0.f) & 0xffffu); }
            continue;
        }
        {
            float* rc = (float*)(p.ws + WS_ROPEC); float* rs = (float*)(p.ws + WS_ROPES);
            for (int idx = tid; idx < 1024; idx += 512) {
                const int pos = idx >> 4, i = idx & 15;
                const float freq = 1.0f / powf(10000.0f, (float)i / 16.0f), ang = (float)pos * freq;
                rc[idx] = cosf(ang); rs[idx] = sinf(ang);
            }
        }
    }
}

__device__ __forceinline__ void phase1(const Params& p) {
    const float* mod = (const float*)(p.ws + WS_MOD); bf16_t* XN = (bf16_t*)(p.ws + WS_XN);
    const int tid_ = opaque_tid(), lane = tid_ & 63, wid = tid_ >> 6;
    const int stride = gridDim.x * 8;
    for (int row0 = blockIdx.x * 8 + wid; row0 < NR; row0 += 2 * stride) {
        f32x4 v[2][8]; float ss[2] = {0.f, 0.f};
#pragma unroll
        for (int r = 0; r < 2; ++r) {
            const int row = (row0 + r * stride < NR) ? row0 + r * stride : row0;
            const float* src = (row < NX) ? p.x + (size_t)row * DM : p.ctx + (size_t)(row - NX) * DM;
#pragma unroll
            for (int i = 0; i < 8; ++i) v[r][i] = __builtin_nontemporal_load((const f32x4*)(src + (i * 64 + lane) * 4));
        }
#pragma unroll
        for (int r = 0; r < 2; ++r) {
#pragma unroll
            for (int i = 0; i < 8; ++i) ss[r] += v[r][i][0] * v[r][i][0] + v[r][i][1] * v[r][i][1] + v[r][i][2] * v[r][i][2] + v[r][i][3] * v[r][i][3];
            ss[r] = wave_sum(ss[r]);
        }
#pragma unroll
        for (int r = 0; r < 2; ++r) {
            const int row = row0 + r * stride;
            if (row < NR) {
                const int b = (row < NX) ? (row >> 12) : 4;
                const float rstd = rsqrtf(ss[r] * (1.0f / DM) + EPS);
#pragma unroll
                for (int i = 0; i < 8; ++i) {
                    const int k = (i * 64 + lane) * 4;
                    const f32x4 g = *(const f32x4*)(p.norm_g + k), sh = *(const f32x4*)(mod + b * 6144 + k), scl = *(const f32x4*)(mod + b * 6144 + 2048 + k);
                    const f32x4 y = (v[r][i] * rstd * g) * (1.0f + scl) + sh;
                    u32x2 w; w.x = pk2(y[0], y[1]); w.y = pk2(y[2], y[3]);
                    *(u32x2*)(XN + (size_t)row * DM + k) = w;
                }
            }
        }
    }
}

__device__ __forceinline__ float softplusf(float v) { return v > 20.0f ? v : log1pf(__expf(v)); }
__device__ __forceinline__ void phase2_dt(const Params& p) {
    const bf16_t* XN = (const bf16_t*)(p.ws + WS_XN); const bf16_t* WDTT = (const bf16_t*)(p.ws + WS_WDTT); float* DT = (float*)(p.ws + WS_DT);
    const int tid_ = opaque_tid(), lane = tid_ & 63, wid = tid_ >> 6, fr = lane & 15, fq = lane >> 4;
    const int G = (int)gridDim.x, nfull = 1448 % G, nlight = G - nfull;
    if ((int)blockIdx.x < nfull) return;
    for (int task = ((int)blockIdx.x - nfull) * 8 + wid; task < NR / 16; task += 8 * nlight) {
        const int r0 = task * 16;
        f32x4 a0 = (f32x4){0.f, 0.f, 0.f, 0.f}, a1 = a0;
        const bf16_t* xa = XN + (size_t)(r0 + fr) * DM + fq * 8;
        const bf16_t* w0 = WDTT + (size_t)fr * DM + fq * 8; const bf16_t* w1 = WDTT + (size_t)(16 + fr) * DM + fq * 8;
#pragma unroll 8
        for (int ks = 0; ks < 64; ++ks) {
            const bf16x8 av = *(const bf16x8*)(xa + ks * 32), b0 = *(const bf16x8*)(w0 + ks * 32), b1 = *(const bf16x8*)(w1 + ks * 32);
            a0 = MFMA16(b0, av, a0); a1 = MFMA16(b1, av, a1);
        }
        const f32x4 bf = *(const f32x4*)(p.dt_bias_f + 4 * fq), bb = *(const f32x4*)(p.dt_bias_b + 4 * fq);
        f32x4 of, ob;
#pragma unroll
        for (int j = 0; j < 4; ++j) { of[j] = softplusf(a0[j] + bf[j]); ob[j] = softplusf(a1[j] + bb[j]); }
        *(f32x4*)(DT + (size_t)(r0 + fr) * 32 + 4 * fq) = of; *(f32x4*)(DT + (size_t)(r0 + fr) * 32 + 16 + 4 * fq) = ob;
    }
}

__device__ __forceinline__ void attn_phase(const Params& p, LAS unsigned char* lds, int n_items) {
    const bf16_t* QB = (const bf16_t*)(p.ws + WS_QB); const bf16_t* KB = (const bf16_t*)(p.ws + WS_KB); const bf16_t* VT = (const bf16_t*)(p.ws + WS_VT);
    const bf16_t* GS = (const bf16_t*)(p.ws + WS_GS); bf16_t* HRAW = (bf16_t*)(p.ws + WS_HRAW);
    const int tid = opaque_tid(), lane = tid & 63, wid = tid >> 6, fr = lane & 15, fq = lane >> 4;
    const int wq = wid & 3;
    u32x4 kreg[2], vreg[2];
    bf16x8 qf[2][2];
    auto tile_src = [&](int item_, int tt, size_t& krow0, int& s0, int& j) {
        const int n_ = (item_ >> 3) & 31, b_ = item_ >> 8;
        if (tt < 2) { krow0 = (size_t)NX + b_ * NCTX + tt * 128; s0 = SEQ + tt * 128; j = 1; }
        else { j = ((n_ == 0) ? 1 : 0) + (tt - 2); const int kb = n_ - 1 + j; krow0 = (size_t)b_ * SEQ + kb * 128; s0 = kb * 128; }
    };
    auto gload = [&](int item_, int tt) {
        size_t krow0; int s0, j; tile_src(item_, tt, krow0, s0, j);
        const int kvh_ = (item_ & 7) >> 1, b_ = item_ >> 8;
#pragma unroll
        for (int i = 0; i < 2; ++i) {
            const int idx = tid + 512 * i;
            { const int key = idx >> 3, sl = idx & 7; kreg[i] = *(const u32x4*)(KB + (krow0 + key) * 256 + kvh_ * 64 + sl * 8); }
            { const int d = idx >> 4, sl = idx & 15; vreg[i] = *(const u32x4*)(VT + ((size_t)(b_ * 4 + kvh_) * 64 + d) * TOKP + s0 + sl * 8); }
        }
    };
    auto lstore = [&](int buf) {
#pragma unroll
        for (int i = 0; i < 2; ++i) {
            const int idx = tid + 512 * i;
            { const int key = idx >> 3, sl = idx & 7; *(LAS u32x4*)(lds + buf * 16384 + key * 128 + ((sl ^ (key & 7)) << 4)) = kreg[i]; }
            { const int d = idx >> 4, sl = idx & 15, kb_ = sl >> 2, s_ = sl & 3, hf_ = (s_ >> 1) * 8;
              LAS unsigned char* vrow = lds + 32768 + buf * 16384 + d * 256;
              *(LAS u32x2*)(vrow + (((kb_ * 4 + ((2 * s_) & 3)) ^ (d & 15)) << 4) + hf_) = (u32x2){vreg[i].x, vreg[i].y};
              *(LAS u32x2*)(vrow + (((kb_ * 4 + ((2 * s_ + 1) & 3)) ^ (d & 15)) << 4) + hf_) = (u32x2){vreg[i].z, vreg[i].w}; }
        }
    };
    auto qload = [&](int item_, bf16x8 (&q)[2][2]) {
        const int hp_ = item_ & 7, n_ = (item_ >> 3) & 31, b_ = item_ >> 8, h_ = hp_ * 2 + (wid >> 2);
#pragma unroll
        for (int qs = 0; qs < 2; ++qs)
#pragma unroll
            for (int ks = 0; ks < 2; ++ks)
                q[qs][ks] = *(const bf16x8*)(QB + (size_t)(b_ * SEQ + n_ * 128 + wq * 32 + qs * 16 + fr) * 1024 + h_ * 64 + ks * 32 + fq * 8);
    };
    int par = 0;
    int item = blockIdx.x;
    if (item < n_items) { qload(item, qf); gload(item, 0); lstore(0); }
    __syncthreads();
    for (; item < n_items; item += gridDim.x) {
    const int hp = item & 7, n = (item >> 3) & 31, b = item >> 8;
    const int h = hp * 2 + (wid >> 2);
    const int T = 5 - (n == 0) - (n == 31);
    const int nxt = item + (int)gridDim.x; const bool has_next = nxt < n_items;
    f32x4 oacc[4][2];
#pragma unroll
    for (int d = 0; d < 4; ++d)
#pragma unroll
        for (int qs = 0; qs < 2; ++qs) oacc[d][qs] = (f32x4){0.f, 0.f, 0.f, 0.f};
    float mrun[2] = {0.f, 0.f}, lrun[2] = {0.f, 0.f};
    for (int tt = 0; tt < T; ++tt) {
        const int buf = (tt + par) & 1;
        if (tt + 1 < T) gload(item, tt + 1);
        else if (has_next) gload(nxt, 0);
        size_t krow0_; int s0_, j; tile_src(item, tt, krow0_, s0_, j);
        LAS unsigned char* Kl = lds + buf * 16384; LAS unsigned char* Vl = lds + 32768 + buf * 16384;
        f32x4 sacc[8][2];
        __builtin_amdgcn_s_setprio(1);
#pragma unroll
        for (int kt = 0; kt < 8; ++kt) {
            sacc[kt][0] = (f32x4){-mrun[0], -mrun[0], -mrun[0], -mrun[0]}; sacc[kt][1] = (f32x4){-mrun[1], -mrun[1], -mrun[1], -mrun[1]};
#pragma unroll
            for (int ks = 0; ks < 2; ++ks) {
                const bf16x8 kf = *(const LAS bf16x8*)(Kl + (kt * 16 + fr) * 128 + (((ks * 4 + fq) ^ (fr & 7)) << 4));
                sacc[kt][0] = MFMA16(kf, qf[0][ks], sacc[kt][0]); sacc[kt][1] = MFMA16(kf, qf[1][ks], sacc[kt][1]);
            }
        }
        __builtin_amdgcn_s_setprio(0);
        if (j != 1) {
            int frm = fr, fqm = fq; asm volatile("" : "+v"(frm), "+v"(fqm));
#pragma unroll
            for (int qs = 0; qs < 2; ++qs) {
                const int rel = 4 * fqm - (wq * 32 + qs * 16 + frm);
                const int srel = (j == 0) ? rel : -rel;
#pragma unroll
                for (int kt = 0; kt < 8; ++kt)
#pragma unroll
                    for (int jj = 0; jj < 4; ++jj) {
                        const int thr = (j == 0) ? -(kt * 16 + jj) : (kt * 16 + jj);
                        if (srel < thr) sacc[kt][qs][jj] = -INFINITY;
                    }
            }
        }
        float mx[2];
#pragma unroll
        for (int qs = 0; qs < 2; ++qs) {
            float m_ = -INFINITY;
#pragma unroll
            for (int kt = 0; kt < 8; ++kt)
#pragma unroll
                for (int jj = 0; jj < 4; ++jj) m_ = fmaxf(m_, sacc[kt][qs][jj]);
            m_ = fmaxf(m_, __shfl_xor(m_, 16)); m_ = fmaxf(m_, __shfl_xor(m_, 32));
            mx[qs] = m_;
        }
        if (!__all(fmaxf(mx[0], mx[1]) <= 8.0f)) {
#pragma unroll
            for (int qs = 0; qs < 2; ++qs) {
                const float delta = fmaxf(mx[qs], 0.0f), alpha = __builtin_amdgcn_exp2f(-delta);
                mrun[qs] += delta; lrun[qs] *= alpha;
#pragma unroll
                for (int d = 0; d < 4; ++d) oacc[d][qs] *= alpha;
#pragma unroll
                for (int kt = 0; kt < 8; ++kt)
#pragma unroll
                    for (int jj = 0; jj < 4; ++jj) sacc[kt][qs][jj] -= delta;
            }
        }
        bf16x8 pf[4][2];
#pragma unroll
        for (int qs = 0; qs < 2; ++qs) {
            float ls = 0.f;
#pragma unroll
            for (int kt = 0; kt < 8; ++kt)
#pragma unroll
                for (int jj = 0; jj < 4; ++jj) { const float e = __builtin_amdgcn_exp2f(sacc[kt][qs][jj]); sacc[kt][qs][jj] = e; ls += e; }
            lrun[qs] += ls;
#pragma unroll
            for (int kb = 0; kb < 4; ++kb) {
                U8 t; t.u.x = pk2(sacc[2 * kb][qs][0], sacc[2 * kb][qs][1]); t.u.y = pk2(sacc[2 * kb][qs][2], sacc[2 * kb][qs][3]);
                t.u.z = pk2(sacc[2 * kb + 1][qs][0], sacc[2 * kb + 1][qs][1]); t.u.w = pk2(sacc[2 * kb + 1][qs][2], sacc[2 * kb + 1][qs][3]);
                pf[kb][qs] = t.h;
            }
        }
        if (tt + 1 == T && has_next) qload(nxt, qf);
        __builtin_amdgcn_s_setprio(1);
#pragma unroll
        for (int kb = 0; kb < 4; ++kb)
#pragma unroll
            for (int d = 0; d < 4; ++d) {
                U8 vf; vf.u = *(const LAS u32x4*)(Vl + (d * 16 + fr) * 256 + (((4 * kb + fq) ^ fr) << 4));
                oacc[d][0] = MFMA16(vf.h, pf[kb][0], oacc[d][0]); oacc[d][1] = MFMA16(vf.h, pf[kb][1], oacc[d][1]);
            }
        __builtin_amdgcn_s_setprio(0);
        if (tt + 1 < T || has_next) lstore(buf ^ 1);
        __syncthreads();
    }
    par = (par + T) & 1;
    const float sk2 = p.sink[h] * LOG2E;
    int fre = fr, fqe = fq; asm volatile("" : "+v"(fre), "+v"(fqe));
    u32x2 gsv[2][4]; f32x4 ngv[4];
#pragma unroll
    for (int d = 0; d < 4; ++d) {
        ngv[d] = *(const f32x4*)(p.att_norm_g + h * 64 + d * 16 + 4 * fqe);
#pragma unroll
        for (int qs = 0; qs < 2; ++qs) gsv[qs][d] = *(const u32x2*)(GS + ((size_t)b * SEQ + n * 128 + wq * 32 + qs * 16 + fre) * 1024 + h * 64 + d * 16 + 4 * fqe);
    }
    __builtin_amdgcn_sched_barrier(0);
#pragma unroll
    for (int qs = 0; qs < 2; ++qs) {
        float l = lrun[qs]; l += __shfl_xor(l, 16); l += __shfl_xor(l, 32);
        l += __builtin_amdgcn_exp2f(sk2 - mrun[qs]);
        const float inv = 1.0f / l;
        const size_t row = (size_t)b * SEQ + n * 128 + wq * 32 + qs * 16 + fre;
        float sq = 0.f;
#pragma unroll
        for (int d = 0; d < 4; ++d) {
            const int col = h * 64 + d * 16 + 4 * fqe;
            const u32x2 g = gsv[qs][d];
            const f32x4 ng = ngv[d];
            const float v0 = oacc[d][qs][0] * inv * bflo(g.x), v1 = oacc[d][qs][1] * inv * bfhi(g.x), v2 = oacc[d][qs][2] * inv * bflo(g.y), v3 = oacc[d][qs][3] * inv * bfhi(g.y);
            sq += v0 * v0 + v1 * v1 + v2 * v2 + v3 * v3;
            u32x2 w; w.x = pk2(v0 * ng[0], v1 * ng[1]); w.y = pk2(v2 * ng[2], v3 * ng[3]);
            *(u32x2*)(HRAW + row * DM + col) = w;
        }
        sq += __shfl_xor(sq, 16); sq += __shfl_xor(sq, 32);
        if (fq == 0) ((float*)(p.ws + WS_SSQA))[row * 16 + h] = sq;
    }
    }
}

__device__ __forceinline__ void conv_phase(const Params& p, LAS unsigned char* lds) {
    const bf16_t* XBC = (const bf16_t*)(p.ws + WS_XBC); bf16_t* XT = (bf16_t*)(p.ws + WS_XT); bf16_t* BT = (bf16_t*)(p.ws + WS_BT); bf16_t* BCN = (bf16_t*)(p.ws + WS_BCN);
    const int tid = opaque_tid();
    const int G16 = (int)gridDim.x >> 4;
    if ((int)blockIdx.x >= G16 * 16) return;
    const int cb = blockIdx.x & 15, ch0 = cb * 128;
    const int t = tid & 31, cs = tid >> 5, ch = ch0 + cs * 8;
    float w0[8], w1[8], w2[8], wb[8];
#pragma unroll
    for (int e = 0; e < 8; ++e) { w0[e] = p.conv_w[ch + e]; w1[e] = p.conv_w[DM + ch + e]; w2[e] = p.conv_w[2 * DM + ch + e]; wb[e] = p.conv_b[ch + e]; }
    LAS unsigned char* R = lds;
    LAS unsigned char* Tt = lds + 18432;
    LAS unsigned char* Nn = lds + 18432 + 18432;
    u32x4 raw[3];
    auto tile_info = [&](int tt, int& b, int& tok0, int& seqlen, int& rowbase, int& sbase) {
        if (tt < 256) { b = tt >> 6; tok0 = (tt & 63) * 64; seqlen = SEQ; rowbase = b * SEQ; sbase = 0; }
        else { const int t2 = tt - 256; b = t2 >> 2; tok0 = (t2 & 3) * 64; seqlen = NCTX; rowbase = NX + b * NCTX; sbase = SEQ; }
    };
    auto gload = [&](int tt) {
        int b, tok0, seqlen, rowbase, sbase; tile_info(tt, b, tok0, seqlen, rowbase, sbase);
#pragma unroll
        for (int i = 0; i < 3; ++i) {
            const int idx = tid + 512 * i, rr = idx >> 4, sl = idx & 15, tok = tok0 - 1 + rr;
            raw[i] = (u32x4){0u, 0u, 0u, 0u};
            if (idx < 66 * 16 && tok >= 0 && tok < seqlen) raw[i] = *(const u32x4*)(XBC + (size_t)(rowbase + tok) * DM + ch0 + sl * 8);
        }
    };
    int tt = blockIdx.x >> 4;
    gload(tt);
    for (; tt < 272; tt += G16) {
        int b, tok0, seqlen, rowbase, sbase; tile_info(tt, b, tok0, seqlen, rowbase, sbase);
#pragma unroll
        for (int i = 0; i < 3; ++i) { const int idx = tid + 512 * i, rr = idx >> 4, sl = idx & 15; if (idx < 66 * 16) *(LAS u32x4*)(R + rr * 272 + sl * 16) = raw[i]; }
        __syncthreads();
        if (tt + G16 < 272) gload(tt + G16);
        {
            u32x4 r[4];
#pragma unroll
            for (int i = 0; i < 4; ++i) r[i] = *(const LAS u32x4*)(R + (2 * t + i) * 272 + cs * 16);
            float u0[8], u1[8];
#pragma unroll
            for (int e2 = 0; e2 < 4; ++e2) {
                float x[4][2];
#pragma unroll
                for (int i = 0; i < 4; ++i) { x[i][0] = bflo(r[i][e2]); x[i][1] = bfhi(r[i][e2]); }
#pragma unroll
                for (int hh = 0; hh < 2; ++hh) {
                    const int e = e2 * 2 + hh;
                    u0[e] = siluf(wb[e] + w0[e] * x[0][hh] + w1[e] * x[1][hh] + w2[e] * x[2][hh]);
                    u1[e] = siluf(wb[e] + w0[e] * x[1][hh] + w1[e] * x[2][hh] + w2[e] * x[3][hh]);
                }
            }
            if (cb < 12) {
#pragma unroll
                for (int e = 0; e < 8; ++e) *(LAS unsigned*)(Tt + (cs * 8 + e) * 144 + t * 4) = pk2(u0[e], u1[e]);
            }
            if (cb >= 8) {
                u32x4 o0, o1;
                o0.x = pk2(u0[0], u0[1]); o0.y = pk2(u0[2], u0[3]); o0.z = pk2(u0[4], u0[5]); o0.w = pk2(u0[6], u0[7]);
                o1.x = pk2(u1[0], u1[1]); o1.y = pk2(u1[2], u1[3]); o1.z = pk2(u1[4], u1[5]); o1.w = pk2(u1[6], u1[7]);
                *(LAS u32x4*)(Nn + (2 * t) * 272 + cs * 16) = o0; *(LAS u32x4*)(Nn + (2 * t + 1) * 272 + cs * 16) = o1;
            }
        }
        __syncthreads();
        if (cb < 12) {
            bf16_t* dst = (cb < 8) ? XT + ((size_t)b * 1024 + ch0) * TOKP : BT + ((size_t)b * 512 + (ch0 - 1024)) * TOKP;
#pragma unroll
            for (int i = 0; i < 2; ++i) {
                const int idx = tid + 512 * i, chl = idx >> 3, sl = idx & 7;
                *(u32x4*)(dst + (size_t)chl * TOKP + sbase + tok0 + sl * 8) = *(const LAS u32x4*)(Tt + chl * 144 + sl * 16);
            }
        }
        if (cb >= 8) {
#pragma unroll
            for (int i = 0; i < 2; ++i) {
                const int idx = tid + 512 * i, tk = idx >> 4, sl = idx & 15;
                *(u32x4*)(BCN + (size_t)(rowbase + tok0 + tk) * 1024 + (ch0 - 1024) + sl * 8) = *(const LAS u32x4*)(Nn + tk * 272 + sl * 16);
            }
        }
    }
    __syncthreads();
}

__device__ __forceinline__ float chunk_tables_hd(const Params& p, LAS float* tab, int row0, int hg, int dir);
__device__ __forceinline__ float chunk_tables(const Params& p, LAS float* tab, int row0, int g) {
    const int w = opaque_tid() >> 6;
    return chunk_tables_hd(p, tab, row0, g * 4 + (w >> 1), w & 1);
}
__device__ __forceinline__ float chunk_tables_hd(const Params& p, LAS float* tab, int row0, int hg, int dir) {
    const float* DT = (const float*)(p.ws + WS_DT);
    const int tid_ = opaque_tid(), lane = tid_ & 63, w = tid_ >> 6;
    const float A = -__expf(dir ? p.a_log_b[hg] : p.a_log_f[hg]);
    const float d0 = DT[(size_t)(row0 + 2 * lane) * 32 + dir * 16 + hg], d1 = DT[(size_t)(row0 + 2 * lane + 1) * 32 + dir * 16 + hg];
    const float a0 = d0 * A, a1 = d1 * A;
    float inc = a0 + a1;
#pragma unroll
    for (int o = 1; o < 64; o <<= 1) { const float t = __shfl_up(inc, o); if (lane >= o) inc += t; }
    const float total = __shfl(inc, 63);
    float c0 = inc - a1, c1 = inc;
    if (dir) { c0 = total - c0 + a0; c1 = total - c1 + a1; }
    LAS float* tb = tab + w * 256;
    tb[2 * lane] = c0; tb[2 * lane + 1] = c1; tb[128 + 2 * lane] = d0; tb[128 + 2 * lane + 1] = d1;
    return total;
}

__device__ __forceinline__ void s1_item(const Params& p, LAS unsigned char* lds, int item) {
    const bf16_t* XT = (const bf16_t*)(p.ws + WS_XT); const bf16_t* BT = (const bf16_t*)(p.ws + WS_BT);
    bf16_t* CS = (bf16_t*)(p.ws + WS_CS); float* DEC = (float*)(p.ws + WS_DEC);
    const int tid = opaque_tid(), lane = tid & 63, w = tid >> 6, fr = lane & 15, fq = lane >> 4;
    const int g = item & 3, cid = (item >> 2) % NSLOT, b = (item >> 2) / NSLOT;
    int row0, s0, slot_f, slot_b;
    if (cid < 2) { row0 = NX + b * NCTX + cid * 128; s0 = SEQ + cid * 128; slot_f = cid; slot_b = 1 - cid; }
    else { const int c = cid - 2; row0 = b * SEQ + c * 128; s0 = c * 128; slot_f = 2 + c; slot_b = 2 + (31 - c); }
    LAS unsigned char* Xl = lds;
    LAS unsigned char* Bl = lds + 65536;
    LAS float* tab = (LAS float*)(lds + 98304);
    LAS float* wS = (LAS float*)(lds + 98304 + 8192);
#pragma unroll
    for (int i = 0; i < 8; ++i) { const int idx = tid + 512 * i, r = idx >> 4, sl = idx & 15;
        *(LAS u32x4*)(Xl + r * 256 + ((sl ^ (r & 15)) << 4)) = *(const u32x4*)(XT + ((size_t)b * 1024 + g * 256 + r) * TOKP + s0 + sl * 8); }
#pragma unroll
    for (int i = 0; i < 4; ++i) { const int idx = tid + 512 * i, r = idx >> 4, sl = idx & 15, rs = (r & ~31) + pg8::perm32(r & 31);
        *(LAS u32x4*)(Bl + r * 256 + ((sl ^ (r & 15)) << 4)) = *(const u32x4*)(BT + ((size_t)b * 512 + g * 128 + rs) * TOKP + s0 + sl * 8); }
    const float total = chunk_tables(p, tab, row0, g);
    const int hl = w >> 1, dir = w & 1, hg = g * 4 + hl, slot = dir ? slot_b : slot_f;
    {
        LAS float* tb = tab + w * 256;
#pragma unroll
        for (int i = 0; i < 2; ++i) { const int l = 2 * lane + i; wS[w * 128 + l] = DBG_W(tb[128 + l] * __expf(total - tb[l])); }
        if (lane == 0) DEC[((b * 2 + dir) * NSLOT + slot) * 16 + hg] = __expf(total);
    }
    __syncthreads();
    bf16_t* dst = CS + ((size_t)((b * 2 + dir) * NSLOT + slot) * 16 + hg) * 8192;
#pragma unroll 1
    for (int pt = 0; pt < 4; ++pt) {
        f32x4 acc[8];
#pragma unroll
        for (int nt = 0; nt < 8; ++nt) acc[nt] = (f32x4){0.f, 0.f, 0.f, 0.f};
#pragma unroll
        for (int ks = 0; ks < 4; ++ks) {
            const int xr = hl * 64 + pt * 16 + fr;
            U8 xa; xa.u = *(const LAS u32x4*)(Xl + xr * 256 + (((ks * 4 + fq) ^ fr) << 4));
            const f32x4 wa = *(const LAS f32x4*)(wS + w * 128 + ks * 32 + fq * 8), wb = *(const LAS f32x4*)(wS + w * 128 + ks * 32 + fq * 8 + 4);
            xa.u.x = pk2(bflo(xa.u.x) * wa[0], bfhi(xa.u.x) * wa[1]); xa.u.y = pk2(bflo(xa.u.y) * wa[2], bfhi(xa.u.y) * wa[3]);
            xa.u.z = pk2(bflo(xa.u.z) * wb[0], bfhi(xa.u.z) * wb[1]); xa.u.w = pk2(bflo(xa.u.w) * wb[2], bfhi(xa.u.w) * wb[3]);
#pragma unroll
            for (int nt = 0; nt < 8; ++nt) {
                const bf16x8 bb = *(const LAS bf16x8*)(Bl + (nt * 16 + fr) * 256 + (((ks * 4 + fq) ^ fr) << 4));
                acc[nt] = MFMA16(bb, xa.h, acc[nt]);
            }
        }
#pragma unroll
        for (int k2 = 0; k2 < 4; ++k2) {
            u32x4 o; o.x = pk2(acc[2 * k2][0], acc[2 * k2][1]); o.y = pk2(acc[2 * k2][2], acc[2 * k2][3]); o.z = pk2(acc[2 * k2 + 1][0], acc[2 * k2 + 1][1]); o.w = pk2(acc[2 * k2 + 1][2], acc[2 * k2 + 1][3]);
            *(u32x4*)(dst + (pt * 16 + fr) * 128 + k2 * 32 + 8 * fq) = o;
        }
    }
    __syncthreads();
}

__device__ __forceinline__ void s1_ctx_item(const Params& p, LAS unsigned char* lds, int sub) {
    const bf16_t* XT = (const bf16_t*)(p.ws + WS_XT); const bf16_t* BT = (const bf16_t*)(p.ws + WS_BT);
    bf16_t* CS = (bf16_t*)(p.ws + WS_CS); float* DEC = (float*)(p.ws + WS_DEC);
    const int tid = opaque_tid(), lane = tid & 63, w = tid >> 6, fr = lane & 15, fq = lane >> 4;
    const int dir = sub & 1, hl = (sub >> 1) & 3, g = (sub >> 3) & 3, cid = (sub >> 5) & 1, b = sub >> 6, hg = g * 4 + hl;
    const int row0 = NX + b * NCTX + cid * 128, s0 = SEQ + cid * 128, slot = dir ? (1 - cid) : cid;
    LAS unsigned char* Xl = lds;
    LAS unsigned char* Bl = lds + 65536;
    LAS float* tab = (LAS float*)(lds + 98304);
    LAS float* wS = (LAS float*)(lds + 98304 + 8192);
#pragma unroll
    for (int i = 0; i < 2; ++i) { const int idx = tid + 512 * i, r = idx >> 4, sl = idx & 15;
        *(LAS u32x4*)(Xl + r * 256 + ((sl ^ (r & 15)) << 4)) = *(const u32x4*)(XT + ((size_t)b * 1024 + hg * 64 + r) * TOKP + s0 + sl * 8); }
#pragma unroll
    for (int i = 0; i < 4; ++i) { const int idx = tid + 512 * i, r = idx >> 4, sl = idx & 15, rs = (r & ~31) + pg8::perm32(r & 31);
        *(LAS u32x4*)(Bl + r * 256 + ((sl ^ (r & 15)) << 4)) = *(const u32x4*)(BT + ((size_t)b * 512 + g * 128 + rs) * TOKP + s0 + sl * 8); }
    const float total = chunk_tables_hd(p, tab, row0, hg, dir);
    {
        LAS float* tb = tab + w * 256;
#pragma unroll
        for (int i = 0; i < 2; ++i) { const int l = 2 * lane + i; wS[w * 128 + l] = tb[128 + l] * __expf(total - tb[l]); }
        if (tid == 0) DEC[((b * 2 + dir) * NSLOT + slot) * 16 + hg] = __expf(total);
    }
    __syncthreads();
    bf16_t* dst = CS + ((size_t)((b * 2 + dir) * NSLOT + slot) * 16 + hg) * 8192;
    const int pt = w >> 1, nt0 = (w & 1) * 4;
    f32x4 acc[4];
#pragma unroll
    for (int nt = 0; nt < 4; ++nt) acc[nt] = (f32x4){0.f, 0.f, 0.f, 0.f};
#pragma unroll
    for (int ks = 0; ks < 4; ++ks) {
        U8 xa; xa.u = *(const LAS u32x4*)(Xl + (pt * 16 + fr) * 256 + (((ks * 4 + fq) ^ fr) << 4));
        const f32x4 wa = *(const LAS f32x4*)(wS + w * 128 + ks * 32 + fq * 8), wb = *(const LAS f32x4*)(wS + w * 128 + ks * 32 + fq * 8 + 4);
        xa.u.x = pk2(bflo(xa.u.x) * wa[0], bfhi(xa.u.x) * wa[1]); xa.u.y = pk2(bflo(xa.u.y) * wa[2], bfhi(xa.u.y) * wa[3]);
        xa.u.z = pk2(bflo(xa.u.z) * wb[0], bfhi(xa.u.z) * wb[1]); xa.u.w = pk2(bflo(xa.u.w) * wb[2], bfhi(xa.u.w) * wb[3]);
#pragma unroll
        for (int nt = 0; nt < 4; ++nt) {
            const bf16x8 bb = *(const LAS bf16x8*)(Bl + ((nt0 + nt) * 16 + fr) * 256 + (((ks * 4 + fq) ^ fr) << 4));
            acc[nt] = MFMA16(bb, xa.h, acc[nt]);
        }
    }
#pragma unroll
    for (int k2 = 0; k2 < 2; ++k2) {
        u32x4 o; o.x = pk2(acc[2 * k2][0], acc[2 * k2][1]); o.y = pk2(acc[2 * k2][2], acc[2 * k2][3]); o.z = pk2(acc[2 * k2 + 1][0], acc[2 * k2 + 1][1]); o.w = pk2(acc[2 * k2 + 1][2], acc[2 * k2 + 1][3]);
        *(u32x4*)(dst + (pt * 16 + fr) * 128 + ((nt0 >> 1) + k2) * 32 + 8 * fq) = o;
    }
    __syncthreads();
}

__device__ __forceinline__ void phase5(const Params& p) {
    const bf16_t* __restrict__ CS = (const bf16_t*)(p.ws + WS_CS); bf16_t* __restrict__ PS = (bf16_t*)(p.ws + WS_PS); const float* __restrict__ DEC = (const float*)(p.ws + WS_DEC);
    const int tid_ = opaque_tid();
    for (int e8 = blockIdx.x * 512 + tid_; e8 < NB * 2 * 16 * 1024; e8 += gridDim.x * 512) {
        const int n8 = (e8 & 1023) * 8, hg = (e8 >> 10) & 15, bd = e8 >> 14;
        float s[8];
#pragma unroll
        for (int e = 0; e < 8; ++e) s[e] = 0.f;
#pragma unroll 1
        for (int s0 = 0; s0 < 33; s0 += 11) {
            u32x4 cv[11]; float dv[11];
#pragma unroll
            for (int k = 0; k < 11; ++k) {
                const int slot = s0 + k;
                cv[k] = *(const u32x4*)(CS + ((size_t)(bd * NSLOT + slot) * 16 + hg) * 8192 + n8); dv[k] = DEC[(bd * NSLOT + slot) * 16 + hg];
            }
#pragma unroll
            for (int k = 0; k < 11; ++k) {
                const int slot = s0 + k;
                if (slot >= 2) { u32x4 o; o.x = pk2(s[0], s[1]); o.y = pk2(s[2], s[3]); o.z = pk2(s[4], s[5]); o.w = pk2(s[6], s[7]); *(u32x4*)(PS + ((size_t)(bd * NSLOT + slot) * 16 + hg) * 8192 + n8) = o; }
                const float d = dv[k];
                s[0] = d * s[0] + bflo(cv[k].x); s[1] = d * s[1] + bfhi(cv[k].x); s[2] = d * s[2] + bflo(cv[k].y); s[3] = d * s[3] + bfhi(cv[k].y);
                s[4] = d * s[4] + bflo(cv[k].z); s[5] = d * s[5] + bfhi(cv[k].z); s[6] = d * s[6] + bflo(cv[k].w); s[7] = d * s[7] + bfhi(cv[k].w);
            }
        }
        { u32x4 o; o.x = pk2(s[0], s[1]); o.y = pk2(s[2], s[3]); o.z = pk2(s[4], s[5]); o.w = pk2(s[6], s[7]); *(u32x4*)(PS + ((size_t)(bd * NSLOT + 33) * 16 + hg) * 8192 + n8) = o; }
    }
}

__device__ __forceinline__ void s3_item(const Params& p, LAS unsigned char* lds, int item) {
    const bf16_t* XT = (const bf16_t*)(p.ws + WS_XT); const bf16_t* BCN = (const bf16_t*)(p.ws + WS_BCN); const bf16_t* PS = (const bf16_t*)(p.ws + WS_PS);
    const bf16_t* ZS = (const bf16_t*)(p.ws + WS_ZS); bf16_t* HRAW = (bf16_t*)(p.ws + WS_HRAW);
    const int tid = opaque_tid(), lane = tid & 63, w = tid >> 6, fr = lane & 15, fq = lane >> 4;
    const int g = item & 3, c = (item >> 2) & 31, b = item >> 7;
    const int row0 = b * SEQ + c * 128, s0 = c * 128, slot_f = 2 + c, slot_b = 2 + (31 - c);
    LAS unsigned char* Xl = lds;
    LAS unsigned char* Cl = lds + 65536;
    LAS unsigned char* Bl = lds + 98304;
    LAS float* tab = (LAS float*)(lds + 131072);
#pragma unroll
    for (int i = 0; i < 8; ++i) { const int idx = tid + 512 * i, r = idx >> 4, sl = idx & 15;
        *(LAS u32x4*)(Xl + r * 256 + ((sl ^ (r & 15)) << 4)) = *(const u32x4*)(XT + ((size_t)b * 1024 + g * 256 + r) * TOKP + s0 + sl * 8); }
#pragma unroll
    for (int i = 0; i < 4; ++i) { const int idx = tid + 512 * i, r = idx >> 4, sl = idx & 15;
        *(LAS u32x4*)(Bl + r * 256 + ((sl ^ (r & 15)) << 4)) = *(const u32x4*)(BCN + (size_t)(row0 + r) * 1024 + g * 128 + sl * 8);
        *(LAS u32x4*)(Cl + r * 256 + ((sl ^ (r & 15)) << 4)) = *(const u32x4*)(BCN + (size_t)(row0 + r) * 1024 + 512 + g * 128 + sl * 8); }
    u32x4 pv[4];
    auto pload = [&](int hl_) {
#pragma unroll
        for (int i = 0; i < 4; ++i) {
            const int idx = tid + 512 * i, dir = idx >> 10, r = (idx >> 4) & 63, sl = idx & 15;
            const int slot = dir ? slot_b : slot_f;
            pv[i] = *(const u32x4*)(PS + ((size_t)((b * 2 + dir) * NSLOT + slot) * 16 + g * 4 + hl_) * 8192 + r * 128 + sl * 8);
        }
    };
    pload(0);
    chunk_tables(p, tab, row0, g);
    __syncthreads();
    bf16x8 cf[4];
#pragma unroll
    for (int ks = 0; ks < 4; ++ks) cf[ks] = *(const LAS bf16x8*)(Cl + (w * 16 + fr) * 256 + (((ks * 4 + fq) ^ fr) << 4));
    f32x4 cb[8];
#pragma unroll
    for (int st = 0; st < 8; ++st) {
        cb[st] = (f32x4){0.f, 0.f, 0.f, 0.f};
#pragma unroll
        for (int ks = 0; ks < 4; ++ks) {
            const bf16x8 bf = *(const LAS bf16x8*)(Bl + (st * 16 + fr) * 256 + (((ks * 4 + fq) ^ fr) << 4));
            cb[st] = MFMA16(bf, cf[ks], cb[st]);
        }
    }
    __syncthreads();
    const int l = w * 16 + fr;
#pragma unroll 1
    for (int hl = 0; hl < 4; ++hl) {
        const int hg = g * 4 + hl;
#pragma unroll
        for (int i = 0; i < 4; ++i) {
            const int idx = tid + 512 * i, dir = idx >> 10, r = (idx >> 4) & 63, sl = idx & 15;
            *(LAS u32x4*)(Bl + dir * 16384 + r * 256 + ((sl ^ (r & 15)) << 4)) = pv[i];
        }
        __syncthreads();
        if (hl < 3) pload(hl + 1);
        u32x2 zv[4]; f32x4 ngv[4];
#pragma unroll
        for (int q = 0; q < 4; ++q) { zv[q] = *(const u32x2*)(ZS + ((size_t)row0 + l) * 1024 + hg * 64 + q * 16 + 4 * fq); ngv[q] = *(const f32x4*)(p.ssd_norm_g + hg * 64 + q * 16 + 4 * fq); }
        LAS float* tf = tab + (hl * 2) * 256; LAS float* tbk = tab + (hl * 2 + 1) * 256;
        const float cfl = tf[l], cbl = tbk[l], dsum = tf[128 + l] + tbk[128 + l], dsk = p.d_skip[hg];
        bf16x8 wf[4];
        int lq = l, fqw = fq; asm volatile("" : "+v"(lq), "+v"(fqw));
#pragma unroll
        for (int sb = 0; sb < 4; ++sb) {
            float wv[8];
#pragma unroll
            for (int half = 0; half < 2; ++half) {
                const int st = 2 * sb + half, sbase = st * 16 + 4 * fq;
                const f32x4 csf = *(const LAS f32x4*)(tf + sbase), dtf = *(const LAS f32x4*)(tf + 128 + sbase);
                const f32x4 csb = *(const LAS f32x4*)(tbk + sbase), dtb = *(const LAS f32x4*)(tbk + 128 + sbase);
#pragma unroll
                for (int j = 0; j < 4; ++j) {
                    const int s = st * 16 + 4 * fqw + j; const float cbv = cb[st][j];
                    const bool fw = s < lq;
                    const float arg = fw ? (cfl - csf[j]) : (cbl - csb[j]), dts = fw ? dtf[j] : dtb[j];
                    float v = cbv * __expf(arg) * dts;
                    if (s == lq) v = cbv * dsum + dsk;
                    wv[half * 4 + j] = v;
                }
            }
            U8 t; t.u.x = pk2(wv[0], wv[1]); t.u.y = pk2(wv[2], wv[3]); t.u.z = pk2(wv[4], wv[5]); t.u.w = pk2(wv[6], wv[7]);
            wf[sb] = t.h;
        }
        const float ef = __expf(cfl), eb = __expf(cbl);
        float sq = 0.f;
#pragma unroll 1
        for (int pt = 0; pt < 4; ++pt) {
            f32x4 y = (f32x4){0.f, 0.f, 0.f, 0.f}, t0 = y, t1 = y;
            const int xr = hl * 64 + pt * 16 + fr;
#pragma unroll
            for (int sb = 0; sb < 4; ++sb) {
                U8 xa;
                const u32x2 lo = *(const LAS u32x2*)(Xl + xr * 256 + (((4 * sb + (fq >> 1)) ^ fr) << 4) + (fq & 1) * 8);
                const u32x2 hi = *(const LAS u32x2*)(Xl + xr * 256 + (((4 * sb + 2 + (fq >> 1)) ^ fr) << 4) + (fq & 1) * 8);
                xa.u.x = lo.x; xa.u.y = lo.y; xa.u.z = hi.x; xa.u.w = hi.y;
                y = MFMA16(xa.h, wf[sb], y);
            }
#pragma unroll
            for (int ks = 0; ks < 4; ++ks) {
                const bf16x8 pa = *(const LAS bf16x8*)(Bl + (pt * 16 + fr) * 256 + (((ks * 4 + fq) ^ fr) << 4));
                const bf16x8 pb = *(const LAS bf16x8*)(Bl + 16384 + (pt * 16 + fr) * 256 + (((ks * 4 + fq) ^ fr) << 4));
                t0 = MFMA16(pa, cf[ks], t0); t1 = MFMA16(pb, cf[ks], t1);
            }
            y += ef * t0 + eb * t1;
            const size_t row = (size_t)row0 + l; const int col = hg * 64 + pt * 16 + 4 * fq;
            const u32x2 z = (pt == 0) ? zv[0] : (pt == 1) ? zv[1] : (pt == 2) ? zv[2] : zv[3];
            const f32x4 ng = (pt == 0) ? ngv[0] : (pt == 1) ? ngv[1] : (pt == 2) ? ngv[2] : ngv[3];
            const float v0 = y[0] * bflo(z.x), v1 = y[1] * bfhi(z.x), v2 = y[2] * bflo(z.y), v3 = y[3] * bfhi(z.y);
            sq += v0 * v0 + v1 * v1 + v2 * v2 + v3 * v3;
            u32x2 o; o.x = pk2(v0 * ng[0], v1 * ng[1]); o.y = pk2(v2 * ng[2], v3 * ng[3]);
            *(u32x2*)(HRAW + row * DM + 1024 + col) = o;
        }
        sq += __shfl_xor(sq, 16); sq += __shfl_xor(sq, 32);
        if (fq == 0) ((float*)(p.ws + WS_SSQS))[((size_t)row0 + l) * 16 + hg] = sq;
        __syncthreads();
    }
}

__device__ __forceinline__ void phase7(const Params& p) {
    bf16_t* HRAW = (bf16_t*)(p.ws + WS_HRAW);
    const int tid_ = opaque_tid(), lane = tid_ & 63, wid = tid_ >> 6;
    const int stride = gridDim.x * 8;
    for (int row0 = blockIdx.x * 8 + wid; row0 < NX; row0 += 4 * stride) {
        u32x4 v[4][4]; float ss[4][2];
#pragma unroll
        for (int r = 0; r < 4; ++r) {
            const int row = (row0 + r * stride < NX) ? row0 + r * stride : row0;
#pragma unroll
            for (int i = 0; i < 4; ++i) v[r][i] = *(const u32x4*)(HRAW + (size_t)row * DM + (i * 64 + lane) * 8);
        }
#pragma unroll
        for (int r = 0; r < 4; ++r) {
            ss[r][0] = 0.f; ss[r][1] = 0.f;
#pragma unroll
            for (int i = 0; i < 4; ++i)
#pragma unroll
                for (int e = 0; e < 4; ++e) { const float a = bflo(v[r][i][e]), c = bfhi(v[r][i][e]); ss[r][i >> 1] += a * a + c * c; }
            ss[r][0] = wave_sum(ss[r][0]); ss[r][1] = wave_sum(ss[r][1]);
        }
#pragma unroll
        for (int r = 0; r < 4; ++r) {
            const int row = row0 + r * stride;
            if (row < NX) {
                const float r0 = rsqrtf(ss[r][0] * (1.0f / 1024.0f) + EPS), r1 = rsqrtf(ss[r][1] * (1.0f / 1024.0f) + EPS);
#pragma unroll
                for (int i = 0; i < 4; ++i) {
                    const int k = (i * 64 + lane) * 8; const float rs = (i < 2) ? r0 : r1;
                    const float* gp = (i < 2) ? p.att_norm_g + k : p.ssd_norm_g + (k - 1024);
                    const f32x4 g0 = *(const f32x4*)gp, g1 = *(const f32x4*)(gp + 4);
                    u32x4 o;
                    o.x = pk2(bflo(v[r][i].x) * rs * g0[0], bfhi(v[r][i].x) * rs * g0[1]); o.y = pk2(bflo(v[r][i].y) * rs * g0[2], bfhi(v[r][i].y) * rs * g0[3]);
                    o.z = pk2(bflo(v[r][i].z) * rs * g1[0], bfhi(v[r][i].z) * rs * g1[1]); o.w = pk2(bflo(v[r][i].w) * rs * g1[2], bfhi(v[r][i].w) * rs * g1[3]);
                    *(u32x4*)(HRAW + (size_t)row * DM + k) = o;
                }
            }
        }
    }
}

__device__ __forceinline__ void phase9(const Params& p) {
    const bf16_t* RB = (const bf16_t*)(p.ws + WS_RB);
    const int tid_ = opaque_tid(), lane = tid_ & 63, wid = tid_ >> 6;
    const int stride = gridDim.x * 8;
    for (int row0 = blockIdx.x * 8 + wid; row0 < NX; row0 += 4 * stride) {
        u32x4 v[4][4]; float ss[4];
#pragma unroll
        for (int r = 0; r < 4; ++r) {
            const int row = (row0 + r * stride < NX) ? row0 + r * stride : row0;
#pragma unroll
            for (int i = 0; i < 4; ++i) v[r][i] = *(const u32x4*)(RB + (size_t)row * DM + (i * 64 + lane) * 8);
        }
#pragma unroll
        for (int r = 0; r < 4; ++r) {
            ss[r] = 0.f;
#pragma unroll
            for (int i = 0; i < 4; ++i)
#pragma unroll
                for (int e = 0; e < 4; ++e) { const float a = bflo(v[r][i][e]), c = bfhi(v[r][i][e]); ss[r] += a * a + c * c; }
            ss[r] = wave_sum(ss[r]);
        }
#pragma unroll
        for (int r = 0; r < 4; ++r) {
            const int row = row0 + r * stride;
            if (row < NX) {
                const float rstd = rsqrtf(ss[r] * (1.0f / DM) + EPS);
#pragma unroll
                for (int i = 0; i < 4; ++i) {
                    const int k = (i * 64 + lane) * 8;
                    const f32x4 g0 = *(const f32x4*)(p.final_norm_g + k), g1 = *(const f32x4*)(p.final_norm_g + k + 4);
                    f32x4 o0, o1;
                    o0[0] = bflo(v[r][i].x) * rstd * g0[0]; o0[1] = bfhi(v[r][i].x) * rstd * g0[1]; o0[2] = bflo(v[r][i].y) * rstd * g0[2]; o0[3] = bfhi(v[r][i].y) * rstd * g0[3];
                    o1[0] = bflo(v[r][i].z) * rstd * g1[0]; o1[1] = bfhi(v[r][i].z) * rstd * g1[1]; o1[2] = bflo(v[r][i].w) * rstd * g1[2]; o1[3] = bfhi(v[r][i].w) * rstd * g1[3];
                    *(f32x4*)(p.out + (size_t)row * DM + k) = o0; *(f32x4*)(p.out + (size_t)row * DM + k + 4) = o1;
                }
            }
        }
    }
}

#define XB_TMO      128
#define XB_XCNT(j)  (256  + 64 * (j))
#define XB_XSUB(j)  (1280 + 64 * (j))
#define XB_XGEN(j)  (2304 + 64 * (j))
#define XB_TOP      3328
#define XB_TOPGEN   3392
#define XCD_BAR_WORDS 3456
#define XB_SPIN_CAP (1u << 22)
__device__ __forceinline__ unsigned xb_ld(unsigned* p)              { return __hip_atomic_load(p, __ATOMIC_RELAXED, __HIP_MEMORY_SCOPE_AGENT); }
__device__ __forceinline__ unsigned xb_add(unsigned* p, unsigned v) { return __hip_atomic_fetch_add(p, v, __ATOMIC_RELAXED, __HIP_MEMORY_SCOPE_AGENT); }
__device__ __forceinline__ unsigned xb_xcc_id() { return (unsigned)__builtin_amdgcn_s_getreg((3 << 11) | 20) & 0xFu; }
#define XB_SPIN(cond, bar) do { unsigned _sp = 0; while (cond) { __builtin_amdgcn_s_sleep(1); \
    if ((++_sp & 255u) == 0u) { if (xb_ld(&(bar)[XB_TMO])) break; if (_sp > XB_SPIN_CAP) { atomicAdd(&(bar)[XB_TMO], 1u); break; } } } } while (0)
struct XcdBarrier { unsigned* bar; unsigned x; volatile LAS unsigned* st; };
__device__ __forceinline__ XcdBarrier xcd_barrier_post(unsigned* bar, volatile LAS unsigned* st) {
    XcdBarrier b; b.bar = bar; b.x = xb_xcc_id(); b.st = st;
    if (threadIdx.x == 0) (void)xb_add(&bar[XB_XCNT(b.x)], 1u);
    return b;
}
__device__ __forceinline__ void xcd_barrier_complete(unsigned* bar, unsigned x, unsigned& nloc, unsigned& nx) {
    const unsigned G = gridDim.x * gridDim.y * gridDim.z;
    unsigned sum, cnt, mine, sp = 0u;
    for (;;) {
        sum = 0u; cnt = 0u; mine = 0u;
#pragma unroll
        for (unsigned j = 0; j < 16; ++j) { const unsigned c = xb_ld(&bar[XB_XCNT(j)]); sum += c; cnt += (c > 0u) ? 1u : 0u; mine = (j == x) ? c : mine; }
        if (sum == G) break;
        __builtin_amdgcn_s_sleep(1);
        if ((++sp & 255u) == 0u) { if (xb_ld(&bar[XB_TMO])) break; if (sp > XB_SPIN_CAP) { atomicAdd(&bar[XB_TMO], 1u); break; } }
    }
    nloc = mine > 0u ? mine : 1u; nx = cnt > 0u ? cnt : 1u;
}
__device__ __forceinline__ void xcd_barrier(const XcdBarrier& b) {
    asm volatile("s_waitcnt vmcnt(0)" ::: "memory");
    __syncthreads();
    if (threadIdx.x == 0) {
        unsigned* bar = b.bar;
        __builtin_amdgcn_s_waitcnt(0);
        unsigned nloc = b.st[0], nx = b.st[1];
        if (nloc == 0u) { xcd_barrier_complete(bar, b.x, nloc, nx); b.st[0] = nloc; b.st[1] = nx; }
        const unsigned old = xb_add(&bar[XB_XSUB(b.x)], 1u);
        const unsigned gen = old / nloc;
        if (old + 1u == (gen + 1u) * nloc) {
            __builtin_amdgcn_fence(__ATOMIC_RELEASE, "agent");
            asm volatile("s_waitcnt vmcnt(0)" ::: "memory");
            const unsigned og = xb_add(&bar[XB_TOP], 1u);
            const unsigned tg = og / nx;
            if (og + 1u == (tg + 1u) * nx) xb_add(&bar[XB_TOPGEN], 1u);
            else XB_SPIN(xb_ld(&bar[XB_TOPGEN]) == tg, bar);
            __builtin_amdgcn_fence(__ATOMIC_ACQUIRE, "agent");
            xb_add(&bar[XB_XGEN(b.x)], 1u);
            asm volatile("s_waitcnt vmcnt(0)" ::: "memory");
        } else {
            XB_SPIN(xb_ld(&bar[XB_XGEN(b.x)]) == gen, bar);
            __builtin_amdgcn_fence(__ATOMIC_ACQUIRE, "agent");
            asm volatile("s_waitcnt vmcnt(0)" ::: "memory");
        }
    }
    __syncthreads();
}

constexpr int N_PHASES = 10;
__global__ void __launch_bounds__(512, 2) hybrid_fwd(Params p) {
    extern __shared__ __attribute__((aligned(16))) unsigned char shm[];
    LAS unsigned char* lds = (LAS unsigned char*)shm;
    cg::grid_group grid = cg::this_grid();
    volatile LAS unsigned* xst = (volatile LAS unsigned*)(lds + LDS_BYTES - 16);
    if (threadIdx.x == 0) { xst[0] = 0u; xst[1] = 0u; }
    __syncthreads();
    const XcdBarrier xb = xcd_barrier_post((unsigned*)(p.ws + WS_BAR), xst);
    if (p.ph_hi > 1000) grid.sync();
#ifdef ONLY_PHASE
#define RUN_PHASE(n) if ((n) == ONLY_PHASE && p.ph_lo <= (n) && (n) < p.ph_hi)
#elif defined(DBG_REPEAT)
#define RUN_PHASE(n) for (int rep_ = 0; rep_ < (((n) == DBG_REPEAT) ? 2 : 1); ++rep_, ((rep_ < (((n) == DBG_REPEAT) ? 2 : 1)) ? xcd_barrier(xb) : (void)0)) if (p.ph_lo <= (n) && (n) < p.ph_hi)
#else
#define RUN_PHASE(n) if (p.ph_lo <= (n) && (n) < p.ph_hi)
#endif
#define SEAM(n) if (p.ph_lo < (n) && (n) < p.ph_hi) xcd_barrier(xb)
#ifdef DBG_XSYNC
    for (int i_ = 0; i_ < DBG_XSYNC; ++i_) xcd_barrier(xb);
#endif
    RUN_PHASE(0) phase0(p, lds);
    SEAM(1);
    RUN_PHASE(1) phase1(p);
    SEAM(2);
    RUN_PHASE(2) {
        phase2_dt(p);
        pg8::Gemm g; g.A = (const bf16_t*)(p.ws + WS_XN); g.Bt = (const bf16_t*)(p.ws + WS_WINT); g.M = NR; g.N = NMAIN; g.K = DM;
        pg8::OrderIn S; S.G = (int)gridDim.x; S.c = (int)blockIdx.x;
        EpiIn E; E.ws = p.ws; E.ropeC = (const float*)(p.ws + WS_ROPEC); E.ropeS = (const float*)(p.ws + WS_ROPES);
        pg8::gemm_phase<EpiIn, pg8::OrderIn>(lds, g, S, E);
    }
    SEAM(3);
    RUN_PHASE(3) {
        constexpr int N_ATT = NB * 32 * 8;
        attn_phase(p, lds, N_ATT);
        conv_phase(p, lds);
#ifdef DBG_CONV2
        conv_phase(p, lds);
#endif
    }
    SEAM(4);
    RUN_PHASE(4) {
        for (int it = blockIdx.x; it < NB * 32 * 4; it += gridDim.x) { const int g = it & 3, c = (it >> 2) & 31, b = it >> 7; s1_item(p, lds, ((b * NSLOT + 2 + c) << 2) | g); }
        for (int sub = blockIdx.x; sub < 256; sub += gridDim.x) s1_ctx_item(p, lds, sub);
    }
    SEAM(5);
    RUN_PHASE(5) phase5(p);
    SEAM(6);
    RUN_PHASE(6) { for (int item = blockIdx.x; item < NB * 32 * 4; item += gridDim.x) s3_item(p, lds, item); }
    SEAM(8);
    RUN_PHASE(8) {
        pg8::Gemm g; g.A = (const bf16_t*)(p.ws + WS_HRAW); g.Bt = (const bf16_t*)(p.ws + WS_WOUTT); g.M = NX; g.N = DM; g.K = DM;
        pg8::StaticOrder S; S.init(NX, DM, (int)gridDim.x, (int)blockIdx.x);
        {
            const int tid = opaque_tid();
            const float* SA = (const float*)(p.ws + WS_SSQA); const float* SY = (const float*)(p.ws + WS_SSQS);
            pg8::Unit uu;
            for (int i = 0; i < MAX_OUT_UNITS && S.next(i, uu); ++i) {
                if (tid < 256) {
                    const size_t row = (size_t)uu.pm * 256 + tid;
                    float sa = 0.f, sy = 0.f;
#pragma unroll
                    for (int q = 0; q < 4; ++q) { const f32x4 a4 = *(const f32x4*)(SA + row * 16 + q * 4), y4 = *(const f32x4*)(SY + row * 16 + q * 4); sa += (a4[0] + a4[1]) + (a4[2] + a4[3]); sy += (y4[0] + y4[1]) + (y4[2] + y4[3]); }
                    const float ra = rsqrtf(sa * (1.0f / 1024.0f) + EPS), ry = rsqrtf(sy * (1.0f / 1024.0f) + EPS);
                    ((LAS float*)(lds + RAT_OFF))[i * 256 + tid] = ra / ry; ((LAS float*)(lds + RSY_OFF))[i * 256 + tid] = ry;
                }
            }
            __syncthreads();
        }
        EpiOut E; E.x = p.x; E.mod = (const float*)(p.ws + WS_MOD); E.rb = (bf16_t*)(p.ws + WS_RB); E.lds = lds;
        pg8::gemm_phase<EpiOut, pg8::StaticOrder>(lds, g, S, E);
    }
    SEAM(9);
    RUN_PHASE(9) phase9(p);
#ifdef DBG_STOP
    RUN_PHASE(10) {
        const int tid_ = opaque_tid(), lane = tid_ & 63, wid = tid_ >> 6;
        for (int row = blockIdx.x * 8 + wid; row < NX; row += gridDim.x * 8) {
            const bf16_t* src = (const bf16_t*)(p.ws + DBG_DUMP) + (size_t)row * DM;
            for (int i = lane; i < DM; i += 64) { float v = __uint_as_float((unsigned)src[i] << 16); if (!(fabsf(v) < 1e30f)) v = 12345.0f; p.out[(size_t)row * DM + i] = v; }
        }
    }
#endif
}

extern "C" void kernel_launch(void* const* d_in, const int* in_sizes, int n_in, void* d_out, int out_size, void* d_ws, size_t ws_size, hipStream_t stream) {
    static int grid = 0;
    if (grid == 0) {
        if (n_in != 20 || in_sizes[0] != NX * DM || out_size != NX * DM || ws_size < WS_END) {
            fprintf(stderr, "kernel_launch: unexpected shapes (n_in %d, in0 %d, out %d, ws %zu need %zu)\n", n_in, n_in > 0 ? in_sizes[0] : -1, out_size, ws_size, (size_t)WS_END); grid = -1; return; }
        int dev = 0, cus = 0, per_cu = 0;
        hipGetDevice(&dev); hipDeviceGetAttribute(&cus, hipDeviceAttributeMultiprocessorCount, dev);
        if (hipFuncSetAttribute((const void*)hybrid_fwd, hipFuncAttributeMaxDynamicSharedMemorySize, LDS_BYTES) != hipSuccess) { fprintf(stderr, "kernel_launch: hipFuncSetAttribute failed\n"); grid = -1; return; }
        if (hipOccupancyMaxActiveBlocksPerMultiprocessor(&per_cu, (const void*)hybrid_fwd, 512, LDS_BYTES) != hipSuccess || per_cu < 1) { fprintf(stderr, "kernel_launch: occupancy query says %d\n", per_cu); per_cu = 1; }
        (void)hipGetLastError();
        grid = cus * 1;
    }
    if (grid < 0) return;
    Params p{};
    const float** pp = (const float**)&p;
    for (int i = 0; i < 20; ++i) pp[i] = (const float*)d_in[i];
    p.out = (float*)d_out; p.ws = (unsigned char*)d_ws;
    if (hipMemsetAsync((char*)d_ws + WS_BAR, 0, XCD_BAR_WORDS * 4, stream) != hipSuccess) { fprintf(stderr, "kernel_launch: memset of barrier words failed\n"); return; }
#if MK_LAUNCHES == 1
    p.ph_lo = 0; p.ph_hi = N_PHASES;
    void* args[] = {&p};
    hipError_t e = hipLaunchCooperativeKernel((const void*)hybrid_fwd, dim3(grid), dim3(512), args, LDS_BYTES, stream);
    if (e != hipSuccess) fprintf(stderr, "cooperative launch failed: %s (grid %d)\n", hipGetErrorString(e), grid);
#else
#ifdef DBG_STOP
    for (int ph = 0; ph <= DBG_STOP; ++ph) { p.ph_lo = ph; p.ph_hi = ph + 1; hipLaunchKernelGGL(hybrid_fwd, dim3(grid), dim3(512), LDS_BYTES, stream, p); }
    p.ph_lo = 10; p.ph_hi = 11; hipLaunchKernelGGL(hybrid_fwd, dim3(grid), dim3(512), LDS_BYTES, stream, p);
#else
    for (int ph = 0; ph < N_PHASES; ++ph) { p.ph_lo = ph; p.ph_hi = ph + 1; hipLaunchKernelGGL(hybrid_fwd, dim3(grid), dim3(512), LDS_BYTES, stream, p); }
#endif
#endif
}
```

```cpp
#include <hip/hip_runtime.h>
#include <hip/hip_cooperative_groups.h>
#include <cstdio>
namespace cg = cooperative_groups;

#ifndef MK_LAUNCHES
#define MK_LAUNCHES 1
#endif

#define DBG_W(x) (x)
#define LAS __attribute__((address_space(3)))
typedef unsigned short bf16_t;
typedef short bf16x8 __attribute__((ext_vector_type(8)));
typedef float f32x4 __attribute__((ext_vector_type(4)));
typedef unsigned u32x4 __attribute__((ext_vector_type(4)));
typedef unsigned u32x2 __attribute__((ext_vector_type(2)));

constexpr int DM = 2048, NB = 4, SEQ = 4096, NCTX = 256;
constexpr int NX = NB * SEQ;
constexpr int NR = NX + NB * NCTX;
constexpr int NIN = 5664, NMAIN = 5632;
constexpr int TOKP = SEQ + NCTX;
constexpr int NSLOT = 34;
constexpr float QSCALE = 0.125f * 1.4426950408889634f;
constexpr float LOG2E = 1.4426950408889634f;
constexpr float EPS = 1e-6f;
constexpr int LDS_BYTES = 147456;

constexpr size_t al256(size_t x) { return (x + 255) & ~(size_t)255; }
constexpr size_t WS_MOD = 0;
constexpr size_t WS_ROPEC = al256(WS_MOD + 5 * 6144 * 4);
constexpr size_t WS_ROPES = al256(WS_ROPEC + 64 * 16 * 4);
constexpr size_t WS_DEC = al256(WS_ROPES + 64 * 16 * 4);
constexpr size_t WS_WINT = al256(WS_DEC + 4 * 2 * NSLOT * 16 * 4);
constexpr size_t WS_WDTT = al256(WS_WINT + (size_t)NMAIN * DM * 2);
constexpr size_t WS_WOUTT = al256(WS_WDTT + 32 * DM * 2);
constexpr size_t WS_XN = al256(WS_WOUTT + (size_t)DM * DM * 2);
constexpr size_t WS_CS = WS_XN;
constexpr size_t WS_QB = al256(WS_XN + (size_t)NR * DM * 2);
constexpr size_t WS_RB = WS_QB;
constexpr size_t WS_KB = al256(WS_QB + (size_t)NX * 1024 * 2);
constexpr size_t WS_VT = al256(WS_KB + (size_t)NR * 256 * 2);
constexpr size_t WS_GS = al256(WS_VT + (size_t)NB * 4 * 64 * TOKP * 2);
constexpr size_t WS_ZS = al256(WS_GS + (size_t)NX * 1024 * 2);
constexpr size_t WS_XBC = al256(WS_ZS + (size_t)NX * 1024 * 2);
constexpr size_t WS_PS = WS_XBC;
constexpr size_t WS_DT = al256(WS_XBC + (size_t)NR * DM * 2);
constexpr size_t WS_XT = al256(WS_DT + (size_t)NR * 32 * 4);
constexpr size_t WS_BT = al256(WS_XT + (size_t)NB * 1024 * TOKP * 2);
constexpr size_t WS_BCN = al256(WS_BT + (size_t)NB * 512 * TOKP * 2);
constexpr size_t WS_HRAW = al256(WS_BCN + (size_t)NR * 1024 * 2);
constexpr size_t WS_BAR = al256(WS_HRAW + (size_t)NX * DM * 2);
constexpr size_t WS_SSQA = al256(WS_BAR + 3456 * 4);
constexpr size_t WS_SSQS = al256(WS_SSQA + (size_t)NX * 16 * 4);
constexpr size_t WS_END = al256(WS_SSQS + (size_t)NX * 16 * 4);
static_assert((size_t)NB * 2 * NSLOT * 16 * 8192 * 2 <= (size_t)NR * DM * 2, "CS/PS alias size");
static_assert(WS_QB + (size_t)NX * DM * 2 <= WS_ZS, "RB alias must end before ZS (read by phase 6)");

struct Params {
    const float *x, *c, *ctx, *c_ctx, *w_mod, *b_mod, *norm_g, *w_in, *conv_w, *conv_b, *a_log_f, *a_log_b, *dt_bias_f, *dt_bias_b, *d_skip,
        *att_norm_g, *ssd_norm_g, *sink, *w_out, *final_norm_g;
    float* out; unsigned char* ws; int ph_lo, ph_hi;
};

typedef float f32x2 __attribute__((ext_vector_type(2)));
typedef __bf16 bf16x2_t __attribute__((ext_vector_type(2)));
__device__ __forceinline__ unsigned pk2(float lo, float hi) { const f32x2 v = {lo, hi}; const bf16x2_t r = __builtin_convertvector(v, bf16x2_t); return __builtin_bit_cast(unsigned, r); }
__device__ __forceinline__ float bflo(unsigned u) { return __uint_as_float(u << 16); }
__device__ __forceinline__ float bfhi(unsigned u) { return __uint_as_float(u & 0xffff0000u); }
__device__ __forceinline__ float siluf(float v) { return v * __builtin_amdgcn_rcpf(1.0f + __expf(-v)); }
__device__ __forceinline__ float wave_sum(float v) {
#pragma unroll
    for (int o = 32; o >= 1; o >>= 1) v += __shfl_xor(v, o);
    return v;
}
__device__ __forceinline__ int opaque_tid() { int t = threadIdx.x; asm volatile("" : "+v"(t)); return t; }
#define MFMA16(a, b, c) __builtin_amdgcn_mfma_f32_16x16x32_bf16((a), (b), (c), 0, 0, 0)
union U8 { u32x4 u; bf16x8 h; };

namespace pg8 {
constexpr int BM = 256, BK = 64, HALF = 128, HTB = HALF * BK * 2, STAGE_BYTES = 8 * HTB, NXCD = 8, WGM = 8;
__device__ __forceinline__ int lds_byte(int r, int c) { const int st = (r >> 4) * 2 + (c >> 5), rr = r & 15, cc = c & 31, ob = rr * 64 + cc * 2; return st * 1024 + (ob ^ (((ob >> 9) & 1) << 5)); }
__device__ __forceinline__ void stage_rc(int b, int& R, int& C) { const int st = b / 1024, sb = b % 1024, swz = sb ^ (((sb >> 9) & 1) << 5); R = (st >> 1) * 16 + swz / 64; C = (st & 1) * 32 + (swz % 64) / 2; }
__device__ __forceinline__ int perm32(int rho) { const int n = rho >> 4, i = rho & 15; return 8 * (i >> 2) + 4 * n + (i & 3); }
struct Unit { int pm, pn; };
struct Gemm { const bf16_t* A; const bf16_t* Bt; int M, N, K; };
__device__ __forceinline__ void static_map(int wgid, int nM, int nN, Unit& u, int WGM = 8) {
    const int nwg = nM * nN;
    { const int q = nwg / NXCD, r = nwg % NXCD, xcd = wgid % NXCD, off = wgid / NXCD; wgid = (xcd < r ? xcd * (q + 1) : r * (q + 1) + (xcd - r) * q) + off; }
    const int nig = WGM * nN, gid = wgid / nig, fm = gid * WGM, gsz = (nM - fm) < WGM ? (nM - fm) : WGM;
    u.pm = fm + ((wgid % nig) % gsz); u.pn = (wgid % nig) / gsz;
}
struct StaticOrder {
    int nM, nN, nwg, G, c;
    __device__ void init(int M, int N, int G_, int c_) { nM = M / BM; nN = N / BM; nwg = nM * nN; G = G_; c = c_; }
    __device__ bool next(int i, Unit& u) const { const long L = (long)i * G + c; if (L >= nwg) return false; static_map((int)L, nM, nN, u, 4); return true; }
};
struct OrderIn {
    int G, c;
    __device__ bool next(int i, Unit& u) const {
        const long L = (long)i * G + c; if (L >= 1448) return false;
        if (L < 1408) { static_map((int)L, 64, 22, u, 4); }
        else { const int e = (int)L - 1408, j = e % 10; u.pm = 64 + e / 10; u.pn = (j == 0) ? 4 : (j == 1) ? 5 : 12 + j; }
        return true;
    }
};

template <class Epi, class Sched>
__device__ __forceinline__ void gemm_phase(LAS unsigned char* lds, const Gemm g, const Sched& S, const Epi& E) {
    const int tid = opaque_tid(), wid = __builtin_amdgcn_readfirstlane(tid >> 6), lane = tid & 63, wr = wid >> 2, wc = wid & 3, fr = lane & 15, fq = lane >> 4;
    const int K = g.K, nt = K / BK;
    unsigned voffA[2], voffB[2];
#pragma unroll
    for (int i = 0; i < 2; ++i) { int R, C; stage_rc(tid * 16 + i * 8192, R, C); const int Rb = Epi::PERM ? ((R & ~31) + perm32(R & 31)) : R;
        voffA[i] = (unsigned)(R * K + C) * 2u; voffB[i] = (unsigned)(Rb * K + C) * 2u; }
    const size_t kstep = (size_t)(BK * 2);
    const size_t hstep = (size_t)HALF * K * 2;
    const size_t tstep = 2 * hstep;
    const unsigned ldsw = (unsigned)wid * 1024u;
    const int aoff = lds_byte(wr * 64 + fr, fq * 8), boff = lds_byte(wc * 32 + fr, fq * 8);
#define PG8_SA(b, h) (((b) * 2 + (h)) * HTB)
#define PG8_SB(b, h) ((4 + (b) * 2 + (h)) * HTB)
#define PG8_STAGE(bufoff, gbase, voff) do { _Pragma("unroll") for (int _i = 0; _i < 2; ++_i) \
        __builtin_amdgcn_global_load_lds((const unsigned*)((const char*)(gbase) + (voff)[_i]), (LAS unsigned*)(lds + (bufoff) + ldsw + _i * 8192), 16, 0, 0); } while (0)
#define PG8_LDA(dst, b, h) do { _Pragma("unroll") for (int m = 0; m < 4; ++m) _Pragma("unroll") for (int k = 0; k < 2; ++k) dst[m][k] = *(const LAS bf16x8*)(lds + PG8_SA(b, h) + aoff + m * 2048 + k * 1024); } while (0)
#define PG8_LDB(dst, b, h) do { _Pragma("unroll") for (int n = 0; n < 2; ++n) _Pragma("unroll") for (int k = 0; k < 2; ++k) dst[n][k] = *(const LAS bf16x8*)(lds + PG8_SB(b, h) + boff + n * 2048 + k * 1024); } while (0)
#define PG8_MMA(ai, bj, At, Bt) do { __builtin_amdgcn_s_setprio(1); _Pragma("unroll") for (int m = 0; m < 4; ++m) _Pragma("unroll") for (int n = 0; n < 2; ++n) _Pragma("unroll") for (int k = 0; k < 2; ++k) \
        acc[ai][bj][m][n] = __builtin_amdgcn_mfma_f32_16x16x32_bf16(Bt[n][k], At[m][k], acc[ai][bj][m][n], 0, 0, 0); __builtin_amdgcn_s_setprio(0); } while (0)
#define PG8_WAIT_V(n) asm volatile("s_waitcnt vmcnt(" #n ")" ::: "memory")
#define PG8_WAIT_L(n) asm volatile("s_waitcnt lgkmcnt(" #n ")" ::: "memory")
#define PG8_BAR __builtin_amdgcn_s_barrier()
#define PG8_SCHED __builtin_amdgcn_sched_barrier(0)
    Unit cur, nxt; int ui = 0;
    if (!S.next(0, cur)) return;
    f32x4 acc[2][2][4][2];
#pragma unroll
    for (int a = 0; a < 2; ++a)
#pragma unroll
        for (int b = 0; b < 2; ++b)
#pragma unroll
            for (int m = 0; m < 4; ++m)
#pragma unroll
                for (int n = 0; n < 2; ++n) acc[a][b][m][n] = (f32x4){0.f, 0.f, 0.f, 0.f};
    bf16x8 At[4][2], B0[2][2], B1[2][2];
    const char* cA = (const char*)g.A + (size_t)cur.pm * tstep; const char* cB = (const char*)g.Bt + (size_t)cur.pn * tstep;
    PG8_STAGE(PG8_SB(0, 0), cB, voffB); PG8_STAGE(PG8_SA(0, 0), cA, voffA); PG8_STAGE(PG8_SB(0, 1), cB + hstep, voffB); PG8_STAGE(PG8_SA(0, 1), cA + hstep, voffA);
    if (wr == 1) PG8_BAR;
    PG8_WAIT_V(4); PG8_BAR;
    PG8_STAGE(PG8_SB(1, 0), cB + kstep, voffB); PG8_STAGE(PG8_SA(1, 0), cA + kstep, voffA); PG8_STAGE(PG8_SB(1, 1), cB + hstep + kstep, voffB);
    PG8_WAIT_V(6); PG8_BAR;
    for (;;) {
        const bool has_next = S.next(ui + 1, nxt);
        const char* nA = has_next ? (const char*)g.A + (size_t)nxt.pm * tstep : cA; const char* nB = has_next ? (const char*)g.Bt + (size_t)nxt.pn * tstep : cB;
        for (int t = 0; t < nt; t += 2) {
            if (Epi::MIDK && t == nt / 2) E.midk(acc, ui, wr, fr);
            const bool last = (t == nt - 2);
            const char* a1 = cA + (size_t)(t + 1) * kstep;
            const char* a2 = last ? nA : cA + (size_t)(t + 2) * kstep; const char* b2 = last ? nB : cB + (size_t)(t + 2) * kstep;
            const char* a3 = a2 + kstep; const char* b3 = b2 + kstep;
            PG8_LDB(B0, 0, 0); PG8_SCHED; PG8_LDA(At, 0, 0); PG8_STAGE(PG8_SA(1, 1), a1 + hstep, voffA);
            PG8_WAIT_L(8); PG8_BAR; PG8_WAIT_L(0); PG8_MMA(0, 0, At, B0); PG8_BAR; PG8_SCHED;
            PG8_LDB(B1, 0, 1); PG8_STAGE(PG8_SB(0, 0), b2, voffB);
            PG8_BAR; PG8_WAIT_L(0); PG8_MMA(0, 1, At, B1); PG8_BAR;
            PG8_LDA(At, 0, 1); PG8_STAGE(PG8_SA(0, 0), a2, voffA);
            PG8_BAR; PG8_WAIT_L(0); PG8_MMA(1, 0, At, B0); PG8_BAR; PG8_SCHED;
            PG8_STAGE(PG8_SB(0, 1), b2 + hstep, voffB);
            PG8_WAIT_V(6); PG8_BAR; PG8_MMA(1, 1, At, B1); PG8_BAR;
            PG8_LDB(B0, 1, 0); PG8_SCHED; PG8_LDA(At, 1, 0); PG8_STAGE(PG8_SA(0, 1), a2 + hstep, voffA);
            PG8_WAIT_L(8); PG8_BAR; PG8_WAIT_L(0); PG8_MMA(0, 0, At, B0); PG8_BAR; PG8_SCHED;
            PG8_LDB(B1, 1, 1); PG8_STAGE(PG8_SB(1, 0), b3, voffB);
            PG8_BAR; PG8_WAIT_L(0); PG8_MMA(0, 1, At, B1); PG8_BAR;
            PG8_LDA(At, 1, 1); PG8_STAGE(PG8_SA(1, 0), a3, voffA);
            PG8_BAR; PG8_WAIT_L(0); PG8_MMA(1, 0, At, B0); PG8_BAR; PG8_SCHED;
            PG8_STAGE(PG8_SB(1, 1), b3 + hstep, voffB);
            PG8_WAIT_V(6); PG8_BAR; PG8_MMA(1, 1, At, B1); PG8_BAR;
        }
        E(acc, cur, ui, wr, wc, fr, fq);
        if (!has_next) break;
#pragma unroll
        for (int a = 0; a < 2; ++a)
#pragma unroll
            for (int b = 0; b < 2; ++b)
#pragma unroll
                for (int m = 0; m < 4; ++m)
#pragma unroll
                    for (int n = 0; n < 2; ++n) acc[a][b][m][n] = (f32x4){0.f, 0.f, 0.f, 0.f};
        cur = nxt; cA = nA; cB = nB; ++ui;
    }
    PG8_WAIT_V(0);
    if (wr == 0) PG8_BAR;
    PG8_BAR;
#undef PG8_SA
#undef PG8_SB
#undef PG8_STAGE
#undef PG8_LDA
#undef PG8_LDB
#undef PG8_MMA
#undef PG8_WAIT_V
#undef PG8_WAIT_L
#undef PG8_BAR
#undef PG8_SCHED
}
}

struct EpiIn {
    static constexpr bool PERM = true, MIDK = false;
    unsigned char* ws; const float *ropeC, *ropeS;
    __device__ __forceinline__ void midk(f32x4 (&)[2][2][4][2], int, int, int) const {}
    __device__ __forceinline__ void operator()(const f32x4 (&acc)[2][2][4][2], const pg8::Unit& u, int, int wr, int wc, int fr, int fq) const {
        asm volatile("" : "+v"(fr), "+v"(fq));
        const int pn = u.pn;
        const int rowb = u.pm * 256 + wr * 64 + fr;
        const int colw = wc * 32 + 8 * fq;
#ifndef EPI_NO_ROPE
        if (pn <= 4) {
            const bool isq = pn < 4, ctxrow = u.pm >= 64;
            bf16_t* base = (bf16_t*)(ws + (isq ? WS_QB : WS_KB)); const int ld = isq ? 1024 : 256, cbase = isq ? pn * 256 : 0;
            const float sc = isq ? QSCALE : 1.0f, sgn = (fq < 2) ? -1.0f : 1.0f;
#pragma unroll
            for (int ai = 0; ai < 2; ++ai)
#pragma unroll
                for (int m = 0; m < 4; ++m) { __builtin_amdgcn_sched_barrier(0);
                    const int row = rowb + ai * 128 + m * 16, s = row & 4095, pos = (wc & 1) ? (s & 63) : (s >> 6);
                    f32x4 c0 = *(const f32x4*)(ropeC + pos * 16 + 8 * (fq & 1)), c1 = *(const f32x4*)(ropeC + pos * 16 + 8 * (fq & 1) + 4);
                    f32x4 s0 = *(const f32x4*)(ropeS + pos * 16 + 8 * (fq & 1)), s1 = *(const f32x4*)(ropeS + pos * 16 + 8 * (fq & 1) + 4);
                    if (ctxrow) { c0 = c1 = (f32x4){1.f, 1.f, 1.f, 1.f}; s0 = s1 = (f32x4){0.f, 0.f, 0.f, 0.f}; }
#pragma unroll
                    for (int bj = 0; bj < 2; ++bj) {
                        const f32x4 v0 = acc[ai][bj][m][0], v1 = acc[ai][bj][m][1]; f32x4 p0, p1;
#pragma unroll
                        for (int j = 0; j < 4; ++j) { p0[j] = __shfl_xor(v0[j], 32); p1[j] = __shfl_xor(v1[j], 32); }
                        const f32x4 o0 = (v0 * c0 + sgn * p0 * s0) * sc, o1 = (v1 * c1 + sgn * p1 * s1) * sc;
                        u32x4 w; w.x = pk2(o0[0], o0[1]); w.y = pk2(o0[2], o0[3]); w.z = pk2(o1[0], o1[1]); w.w = pk2(o1[2], o1[3]);
                        *(u32x4*)(base + (size_t)row * ld + cbase + bj * 128 + colw) = w;
                        __builtin_amdgcn_sched_barrier(0);
                    }
                }
        } else
#endif
#ifndef EPI_NO_V
        if (pn == 5) {
            bf16_t* VT = (bf16_t*)(ws + WS_VT);
#pragma unroll
            for (int ai = 0; ai < 2; ++ai)
#pragma unroll
                for (int m = 0; m < 4; ++m) { __builtin_amdgcn_sched_barrier(0);
                    const int row = rowb + ai * 128 + m * 16;
                    int b, s; if (row < NX) { b = row >> 12; s = row & 4095; } else { b = (row - NX) >> 8; s = SEQ + ((row - NX) & 255); }
#pragma unroll
                    for (int bj = 0; bj < 2; ++bj)
#pragma unroll
                        for (int n = 0; n < 2; ++n)
#pragma unroll
                            for (int j = 0; j < 4; ++j) {
                                const int col = bj * 128 + colw + 4 * n + j;
                                VT[((size_t)(b * 4 + (col >> 6)) * 64 + (col & 63)) * TOKP + s] = (bf16_t)(pk2(acc[ai][bj][m][n][j], 0.f) & 0xffffu);
                            }
                }
        } else
#endif
        {
            const bool act = pn < 14;
            bf16_t* base = (bf16_t*)(ws + ((pn < 10) ? WS_GS : (pn < 14) ? WS_ZS : WS_XBC));
            const int ld = act ? 1024 : 2048, cbase = (pn < 10) ? (pn - 6) * 256 : (pn < 14) ? (pn - 10) * 256 : (pn - 14) * 256;
#pragma unroll
            for (int ai = 0; ai < 2; ++ai)
#pragma unroll
                for (int m = 0; m < 4; ++m) { __builtin_amdgcn_sched_barrier(0);
                    const int row = rowb + ai * 128 + m * 16;
#pragma unroll
                    for (int bj = 0; bj < 2; ++bj) {
                        f32x4 v0 = acc[ai][bj][m][0], v1 = acc[ai][bj][m][1];
                        if (act) {
#pragma unroll
                            for (int j = 0; j < 4; ++j) { v0[j] = siluf(v0[j]); v1[j] = siluf(v1[j]); }
                        }
                        u32x4 w; w.x = pk2(v0[0], v0[1]); w.y = pk2(v0[2], v0[3]); w.z = pk2(v1[0], v1[1]); w.w = pk2(v1[2], v1[3]);
                        *(u32x4*)(base + (size_t)row * ld + cbase + bj * 128 + colw) = w;
                        __builtin_amdgcn_sched_barrier(0);
                    }
                }
        }
    }
};
constexpr int RAT_OFF = 131072, RSY_OFF = 131072 + 6 * 256 * 4, MAX_OUT_UNITS = 6;
struct EpiOut {
    static constexpr bool PERM = true, MIDK = true;
    const float* x; const float* mod; bf16_t* rb; LAS unsigned char* lds;
    __device__ __forceinline__ void midk(f32x4 (&acc)[2][2][4][2], int ui, int wr, int fr) const {
        const LAS float* rat = (const LAS float*)(lds + RAT_OFF) + ui * 256 + wr * 64 + fr;
#pragma unroll
        for (int ai = 0; ai < 2; ++ai)
#pragma unroll
            for (int m = 0; m < 4; ++m) {
                const float r = rat[ai * 128 + m * 16];
#pragma unroll
                for (int bj = 0; bj < 2; ++bj)
#pragma unroll
                    for (int n = 0; n < 2; ++n) acc[ai][bj][m][n] *= r;
            }
    }
    __device__ __forceinline__ void operator()(const f32x4 (&acc)[2][2][4][2], const pg8::Unit& u, int ui, int wr, int wc, int fr, int fq) const {
        asm volatile("" : "+v"(fr), "+v"(fq));
        const int row0 = u.pm * 256 + wr * 64 + fr, col0 = u.pn * 256 + wc * 32 + 8 * fq;
        const int b = (u.pm * 256) >> 12;
        const LAS float* rsy = (const LAS float*)(lds + RSY_OFF) + ui * 256 + wr * 64 + fr;
        f32x4 gv[2][2];
#pragma unroll
        for (int bj = 0; bj < 2; ++bj)
#pragma unroll
            for (int n = 0; n < 2; ++n) gv[bj][n] = *(const f32x4*)(mod + b * 6144 + 4096 + col0 + bj * 128 + n * 4);
#pragma unroll
        for (int ai = 0; ai < 2; ++ai) {
            f32x4 xv[4][2][2];
#pragma unroll
            for (int m = 0; m < 4; ++m) {
                const size_t ro = (size_t)(row0 + ai * 128 + m * 16) * DM + col0;
#pragma unroll
                for (int bj = 0; bj < 2; ++bj) { xv[m][bj][0] = __builtin_nontemporal_load((const f32x4*)(x + ro + bj * 128)); xv[m][bj][1] = __builtin_nontemporal_load((const f32x4*)(x + ro + bj * 128 + 4)); }
            }
            __builtin_amdgcn_sched_barrier(0);
#pragma unroll
            for (int m = 0; m < 4; ++m) {
                const size_t ro = (size_t)(row0 + ai * 128 + m * 16) * DM + col0;
                const float ry = rsy[ai * 128 + m * 16];
#pragma unroll
                for (int bj = 0; bj < 2; ++bj) {
                    const f32x4 r0 = xv[m][bj][0] + gv[bj][0] * (ry * acc[ai][bj][m][0]), r1 = xv[m][bj][1] + gv[bj][1] * (ry * acc[ai][bj][m][1]);
                    u32x4 w; w.x = pk2(r0[0], r0[1]); w.y = pk2(r0[2], r0[3]); w.z = pk2(r1[0], r1[1]); w.w = pk2(r1[2], r1[3]);
                    *(u32x4*)(rb + ro + bj * 128) = w;
                }
            }
            __builtin_amdgcn_sched_barrier(0);
        }
    }
};

__device__ __forceinline__ void p0_mod_item(const Params& p, LAS unsigned char* lds, int item) {
    LAS float* sc = (LAS float*)lds;
    LAS float* red = (LAS float*)(lds + 5 * 2048 * 4);
    const int tid = opaque_tid(), c0 = item * 32;
    for (int idx = tid; idx < 5 * 2048; idx += 512) { const int b = idx >> 11, k = idx & 2047; const float v = (b < 4) ? p.c[b * 2048 + k] : p.c_ctx[k]; sc[idx] = siluf(v); }
    __syncthreads();
    const int rr = tid >> 3, pc = tid & 7;
    f32x4 a[5];
#pragma unroll
    for (int b = 0; b < 5; ++b) a[b] = (f32x4){0.f, 0.f, 0.f, 0.f};
    const float* wp = p.w_mod + (size_t)rr * 6144 + c0 + 4 * pc;
#pragma unroll 8
    for (int i = 0; i < 32; ++i) {
        const f32x4 w = __builtin_nontemporal_load((const f32x4*)(wp + (size_t)i * 64 * 6144));
        const int row = i * 64 + rr;
#pragma unroll
        for (int b = 0; b < 5; ++b) a[b] += sc[b * 2048 + row] * w;
    }
#pragma unroll
    for (int b = 0; b < 5; ++b)
#pragma unroll
        for (int j = 0; j < 4; ++j) red[(rr * 8 + pc) * 20 + b * 4 + j] = a[b][j];
    __syncthreads();
    if (tid < 160) {
        const int b = tid >> 5, col = tid & 31, pcc = col >> 2, j = col & 3; float s = 0.f;
        for (int r = 0; r < 64; ++r) s += red[(r * 8 + pcc) * 20 + b * 4 + j];
        ((float*)(p.ws + WS_MOD))[b * 6144 + c0 + col] = s + p.b_mod[c0 + col];
    }
    __syncthreads();
}
__device__ __forceinline__ void p0_transpose_item(LAS unsigned char* lds, const float* src, int ldn, int k0, int n0, bf16_t* dst) {
    LAS float* T = (LAS float*)lds;
    const int tid = opaque_tid();
    f32x4 v[4];
#pragma unroll
    for (int i = 0; i < 4; ++i) { const int idx = tid + 512 * i, kr = idx >> 5, q = idx & 31; v[i] = __builtin_nontemporal_load((const f32x4*)(src + (size_t)(k0 + kr) * ldn + n0 + 4 * q)); }
#pragma unroll
    for (int i = 0; i < 4; ++i) { const int idx = tid + 512 * i, kr = idx >> 5, q = idx & 31;
#pragma unroll
        for (int j = 0; j < 4; ++j) T[(4 * q + j) * 65 + kr] = v[i][j]; }
    __syncthreads();
#pragma unroll
    for (int i = 0; i < 2; ++i) {
        const int idx = tid + 512 * i, n = idx >> 3, ks = idx & 7;
        float f[8];
#pragma unroll
        for (int e = 0; e < 8; ++e) f[e] = T[n * 65 + ks * 8 + e];
        u32x4 w; w.x = pk2(f[0], f[1]); w.y = pk2(f[2], f[3]); w.z = pk2(f[4], f[5]); w.w = pk2(f[6], f[7]);
        *(u32x4*)(dst + (size_t)(n0 + n) * 2048 + k0 + ks * 8) = w;
    }
    __syncthreads();
}
__device__ __forceinline__ void phase0(const Params& p, LAS unsigned char* lds) {
    bf16_t* WINT = (bf16_t*)(p.ws + WS_WINT); bf16_t* WDTT = (bf16_t*)(p.ws + WS_WDTT); bf16_t* WOUTT = (bf16_t*)(p.ws + WS_WOUTT);
    const int tid = opaque_tid();
    constexpr int N_MOD = 192, N_TIN = 1408, N_TOUT = 512, N_TDT = 32, N_ROPE = 1;
    constexpr int TOTAL = N_MOD + N_TIN + N_TOUT + N_TDT + N_ROPE;
    for (int item = blockIdx.x; item < TOTAL; item += gridDim.x) {
        int it = item;
        if (it < N_MOD) { p0_mod_item(p, lds, it); continue; }
        it -= N_MOD;
        if (it < N_TIN) { p0_transpose_item(lds, p.w_in, NIN, (it & 31) * 64, (it >> 5) * 128, WINT); continue; }
        it -= N_TIN;
        if (it < N_TOUT) { p0_transpose_item(lds, p.w_out, DM, (it & 31) * 64, (it >> 5) * 128, WOUTT); continue; }
        it -= N_TOUT;
        if (it < N_TDT) {
            const int k0 = it * 64;
#pragma unroll
            for (int i = 0; i < 4; ++i) { const int idx = tid + 512 * i, n = idx & 31, kr = idx >> 5;
                WDTT[(size_t)n * 2048 + k0 + kr] = (bf16_t)(pk2(p.w_in[(size_t)(k0 + kr) * NIN + NMAIN + n], 0.f) & 0xffffu); }
            continue;
        }
        {
            float* rc = (float*)(p.ws + WS_ROPEC); float* rs = (float*)(p.ws + WS_ROPES);
            for (int idx = tid; idx < 1024; idx += 512) {
                const int pos = idx >> 4, i = idx & 15;
                const float freq = 1.0f / powf(10000.0f, (float)i / 16.0f), ang = (float)pos * freq;
                rc[idx] = cosf(ang); rs[idx] = sinf(ang);
            }
        }
    }
}

__device__ __forceinline__ void phase1(const Params& p) {
    const float* mod = (const float*)(p.ws + WS_MOD); bf16_t* XN = (bf16_t*)(p.ws + WS_XN);
    const int tid_ = opaque_tid(), lane = tid_ & 63, wid = tid_ >> 6;
    const int stride = gridDim.x * 8;
    for (int row0 = blockIdx.x * 8 + wid; row0 < NR; row0 += 2 * stride) {
        f32x4 v[2][8]; float ss[2] = {0.f, 0.f};
#pragma unroll
        for (int r = 0; r < 2; ++r) {
            const int row = (row0 + r * stride < NR) ? row0 + r * stride : row0;
            const float* src = (row < NX) ? p.x + (size_t)row * DM : p.ctx + (size_t)(row - NX) * DM;
#pragma unroll
            for (int i = 0; i < 8; ++i) v[r][i] = __builtin_nontemporal_load((const f32x4*)(src + (i * 64 + lane) * 4));
        }
#pragma unroll
        for (int r = 0; r < 2; ++r) {
#pragma unroll
            for (int i = 0; i < 8; ++i) ss[r] += v[r][i][0] * v[r][i][0] + v[r][i][1] * v[r][i][1] + v[r][i][2] * v[r][i][2] + v[r][i][3] * v[r][i][3];
            ss[r] = wave_sum(ss[r]);
        }
#pragma unroll
        for (int r = 0; r < 2; ++r) {
            const int row = row0 + r * stride;
            if (row < NR) {
                const int b = (row < NX) ? (row >> 12) : 4;
                const float rstd = rsqrtf(ss[r] * (1.0f / DM) + EPS);
#pragma unroll
                for (int i = 0; i < 8; ++i) {
                    const int k = (i * 64 + lane) * 4;
                    const f32x4 g = *(const f32x4*)(p.norm_g + k), sh = *(const f32x4*)(mod + b * 6144 + k), scl = *(const f32x4*)(mod + b * 6144 + 2048 + k);
                    const f32x4 y = (v[r][i] * rstd * g) * (1.0f + scl) + sh;
                    u32x2 w; w.x = pk2(y[0], y[1]); w.y = pk2(y[2], y[3]);
                    *(u32x2*)(XN + (size_t)row * DM + k) = w;
                }
            }
        }
    }
}

__device__ __forceinline__ float softplusf(float v) { return v > 20.0f ? v : log1pf(__expf(v)); }
__device__ __forceinline__ void phase2_dt(const Params& p) {
    const bf16_t* XN = (const bf16_t*)(p.ws + WS_XN); const bf16_t* WDTT = (const bf16_t*)(p.ws + WS_WDTT); float* DT = (float*)(p.ws + WS_DT);
    const int tid_ = opaque_tid(), lane = tid_ & 63, wid = tid_ >> 6, fr = lane & 15, fq = lane >> 4;
    const int G = (int)gridDim.x, nfull = 1448 % G, nlight = G - nfull;
    if ((int)blockIdx.x < nfull) return;
    for (int task = ((int)blockIdx.x - nfull) * 8 + wid; task < NR / 16; task += 8 * nlight) {
        const int r0 = task * 16;
        f32x4 a0 = (f32x4){0.f, 0.f, 0.f, 0.f}, a1 = a0;
        const bf16_t* xa = XN + (size_t)(r0 + fr) * DM + fq * 8;
        const bf16_t* w0 = WDTT + (size_t)fr * DM + fq * 8; const bf16_t* w1 = WDTT + (size_t)(16 + fr) * DM + fq * 8;
#pragma unroll 8
        for (int ks = 0; ks < 64; ++ks) {
            const bf16x8 av = *(const bf16x8*)(xa + ks * 32), b0 = *(const bf16x8*)(w0 + ks * 32), b1 = *(const bf16x8*)(w1 + ks * 32);
            a0 = MFMA16(b0, av, a0); a1 = MFMA16(b1, av, a1);
        }
        const f32x4 bf = *(const f32x4*)(p.dt_bias_f + 4 * fq), bb = *(const f32x4*)(p.dt_bias_b + 4 * fq);
        f32x4 of, ob;
#pragma unroll
        for (int j = 0; j < 4; ++j) { of[j] = softplusf(a0[j] + bf[j]); ob[j] = softplusf(a1[j] + bb[j]); }
        *(f32x4*)(DT + (size_t)(r0 + fr) * 32 + 4 * fq) = of; *(f32x4*)(DT + (size_t)(r0 + fr) * 32 + 16 + 4 * fq) = ob;
    }
}

__device__ __forceinline__ void attn_phase(const Params& p, LAS unsigned char* lds, int n_items) {
    const bf16_t* QB = (const bf16_t*)(p.ws + WS_QB); const bf16_t* KB = (const bf16_t*)(p.ws + WS_KB); const bf16_t* VT = (const bf16_t*)(p.ws + WS_VT);
    const bf16_t* GS = (const bf16_t*)(p.ws + WS_GS); bf16_t* HRAW = (bf16_t*)(p.ws + WS_HRAW);
    const int tid = opaque_tid(), lane = tid & 63, wid = tid >> 6, fr = lane & 15, fq = lane >> 4;
    const int wq = wid & 3;
    u32x4 kreg[2], vreg[2];
    bf16x8 qf[2][2];
    auto tile_src = [&](int item_, int tt, size_t& krow0, int& s0, int& j) {
        const int n_ = (item_ >> 3) & 31, b_ = item_ >> 8;
        if (tt < 2) { krow0 = (size_t)NX + b_ * NCTX + tt * 128; s0 = SEQ + tt * 128; j = 1; }
        else { j = ((n_ == 0) ? 1 : 0) + (tt - 2); const int kb = n_ - 1 + j; krow0 = (size_t)b_ * SEQ + kb * 128; s0 = kb * 128; }
    };
    auto gload = [&](int item_, int tt) {
        size_t krow0; int s0, j; tile_src(item_, tt, krow0, s0, j);
        const int kvh_ = (item_ & 7) >> 1, b_ = item_ >> 8;
#pragma unroll
        for (int i = 0; i < 2; ++i) {
            const int idx = tid + 512 * i;
            { const int key = idx >> 3, sl = idx & 7; kreg[i] = *(const u32x4*)(KB + (krow0 + key) * 256 + kvh_ * 64 + sl * 8); }
            { const int d = idx >> 4, sl = idx & 15; vreg[i] = *(const u32x4*)(VT + ((size_t)(b_ * 4 + kvh_) * 64 + d) * TOKP + s0 + sl * 8); }
        }
    };
    auto lstore = [&](int buf) {
#pragma unroll
        for (int i = 0; i < 2; ++i) {
            const int idx = tid + 512 * i;
            { const int key = idx >> 3, sl = idx & 7; *(LAS u32x4*)(lds + buf * 16384 + key * 128 + ((sl ^ (key & 7)) << 4)) = kreg[i]; }
            { const int d = idx >> 4, sl = idx & 15, kb_ = sl >> 2, s_ = sl & 3, hf_ = (s_ >> 1) * 8;
              LAS unsigned char* vrow = lds + 32768 + buf * 16384 + d * 256;
              *(LAS u32x2*)(vrow + (((kb_ * 4 + ((2 * s_) & 3)) ^ (d & 15)) << 4) + hf_) = (u32x2){vreg[i].x, vreg[i].y};
              *(LAS u32x2*)(vrow + (((kb_ * 4 + ((2 * s_ + 1) & 3)) ^ (d & 15)) << 4) + hf_) = (u32x2){vreg[i].z, vreg[i].w}; }
        }
    };
    auto qload = [&](int item_, bf16x8 (&q)[2][2]) {
        const int hp_ = item_ & 7, n_ = (item_ >> 3) & 31, b_ = item_ >> 8, h_ = hp_ * 2 + (wid >> 2);
#pragma unroll
        for (int qs = 0; qs < 2; ++qs)
#pragma unroll
            for (int ks = 0; ks < 2; ++ks)
                q[qs][ks] = *(const bf16x8*)(QB + (size_t)(b_ * SEQ + n_ * 128 + wq * 32 + qs * 16 + fr) * 1024 + h_ * 64 + ks * 32 + fq * 8);
    };
    int par = 0;
    int item = blockIdx.x;
    if (item < n_items) { qload(item, qf); gload(item, 0); lstore(0); }
    __syncthreads();
    for (; item < n_items; item += gridDim.x) {
    const int hp = item & 7, n = (item >> 3) & 31, b = item >> 8;
    const int h = hp * 2 + (wid >> 2);
    const int T = 5 - (n == 0) - (n == 31);
    const int nxt = item + (int)gridDim.x; const bool has_next = nxt < n_items;
    f32x4 oacc[4][2];
#pragma unroll
    for (int d = 0; d < 4; ++d)
#pragma unroll
        for (int qs = 0; qs < 2; ++qs) oacc[d][qs] = (f32x4){0.f, 0.f, 0.f, 0.f};
    float mrun[2] = {0.f, 0.f}, lrun[2] = {0.f, 0.f};
    for (int tt = 0; tt < T; ++tt) {
        const int buf = (tt + par) & 1;
        if (tt + 1 < T) gload(item, tt + 1);
        else if (has_next) gload(nxt, 0);
        size_t krow0_; int s0_, j; tile_src(item, tt, krow0_, s0_, j);
        LAS unsigned char* Kl = lds + buf * 16384; LAS unsigned char* Vl = lds + 32768 + buf * 16384;
        f32x4 sacc[8][2];
        __builtin_amdgcn_s_setprio(1);
#pragma unroll
        for (int kt = 0; kt < 8; ++kt) {
            sacc[kt][0] = (f32x4){-mrun[0], -mrun[0], -mrun[0], -mrun[0]}; sacc[kt][1] = (f32x4){-mrun[1], -mrun[1], -mrun[1], -mrun[1]};
#pragma unroll
            for (int ks = 0; ks < 2; ++ks) {
                const bf16x8 kf = *(const LAS bf16x8*)(Kl + (kt * 16 + fr) * 128 + (((ks * 4 + fq) ^ (fr & 7)) << 4));
                sacc[kt][0] = MFMA16(kf, qf[0][ks], sacc[kt][0]); sacc[kt][1] = MFMA16(kf, qf[1][ks], sacc[kt][1]);
            }
        }
        __builtin_amdgcn_s_setprio(0);
        if (j != 1) {
            int frm = fr, fqm = fq; asm volatile("" : "+v"(frm), "+v"(fqm));
#pragma unroll
            for (int qs = 0; qs < 2; ++qs) {
                const int rel = 4 * fqm - (wq * 32 + qs * 16 + frm);
                const int srel = (j == 0) ? rel : -rel;
#pragma unroll
                for (int kt = 0; kt < 8; ++kt)
#pragma unroll
                    for (int jj = 0; jj < 4; ++jj) {
                        const int thr = (j == 0) ? -(kt * 16 + jj) : (kt * 16 + jj);
                        if (srel < thr) sacc[kt][qs][jj] = -INFINITY;
                    }
            }
        }
        float mx[2];
#pragma unroll
        for (int qs = 0; qs < 2; ++qs) {
            float m_ = -INFINITY;
#pragma unroll
            for (int kt = 0; kt < 8; ++kt)
#pragma unroll
                for (int jj = 0; jj < 4; ++jj) m_ = fmaxf(m_, sacc[kt][qs][jj]);
            m_ = fmaxf(m_, __shfl_xor(m_, 16)); m_ = fmaxf(m_, __shfl_xor(m_, 32));
            mx[qs] = m_;
        }
        if (!__all(fmaxf(mx[0], mx[1]) <= 8.0f)) {
#pragma unroll
            for (int qs = 0; qs < 2; ++qs) {
                const float delta = fmaxf(mx[qs], 0.0f), alpha = __builtin_amdgcn_exp2f(-delta);
                mrun[qs] += delta; lrun[qs] *= alpha;
#pragma unroll
                for (int d = 0; d < 4; ++d) oacc[d][qs] *= alpha;
#pragma unroll
                for (int kt = 0; kt < 8; ++kt)
#pragma unroll
                    for (int jj = 0; jj < 4; ++jj) sacc[kt][qs][jj] -= delta;
            }
        }
        bf16x8 pf[4][2];
#pragma unroll
        for (int qs = 0; qs < 2; ++qs) {
            float ls = 0.f;
#pragma unroll
            for (int kt = 0; kt < 8; ++kt)
#pragma unroll
                for (int jj = 0; jj < 4; ++jj) { const float e = __builtin_amdgcn_exp2f(sacc[kt][qs][jj]); sacc[kt][qs][jj] = e; ls += e; }
            lrun[qs] += ls;
#pragma unroll
            for (int kb = 0; kb < 4; ++kb) {
                U8 t; t.u.x = pk2(sacc[2 * kb][qs][0], sacc[2 * kb][qs][1]); t.u.y = pk2(sacc[2 * kb][qs][2], sacc[2 * kb][qs][3]);
                t.u.z = pk2(sacc[2 * kb + 1][qs][0], sacc[2 * kb + 1][qs][1]); t.u.w = pk2(sacc[2 * kb + 1][qs][2], sacc[2 * kb + 1][qs][3]);
                pf[kb][qs] = t.h;
            }
        }
        if (tt + 1 == T && has_next) qload(nxt, qf);
        __builtin_amdgcn_s_setprio(1);
#pragma unroll
        for (int kb = 0; kb < 4; ++kb)
#pragma unroll
            for (int d = 0; d < 4; ++d) {
                U8 vf; vf.u = *(const LAS u32x4*)(Vl + (d * 16 + fr) * 256 + (((4 * kb + fq) ^ fr) << 4));
                oacc[d][0] = MFMA16(vf.h, pf[kb][0], oacc[d][0]); oacc[d][1] = MFMA16(vf.h, pf[kb][1], oacc[d][1]);
            }
        __builtin_amdgcn_s_setprio(0);
        if (tt + 1 < T || has_next) lstore(buf ^ 1);
        __syncthreads();
    }
    par = (par + T) & 1;
    const float sk2 = p.sink[h] * LOG2E;
    int fre = fr, fqe = fq; asm volatile("" : "+v"(fre), "+v"(fqe));
    u32x2 gsv[2][4]; f32x4 ngv[4];
#pragma unroll
    for (int d = 0; d < 4; ++d) {
        ngv[d] = *(const f32x4*)(p.att_norm_g + h * 64 + d * 16 + 4 * fqe);
#pragma unroll
        for (int qs = 0; qs < 2; ++qs) gsv[qs][d] = *(const u32x2*)(GS + ((size_t)b * SEQ + n * 128 + wq * 32 + qs * 16 + fre) * 1024 + h * 64 + d * 16 + 4 * fqe);
    }
    __builtin_amdgcn_sched_barrier(0);
#pragma unroll
    for (int qs = 0; qs < 2; ++qs) {
        float l = lrun[qs]; l += __shfl_xor(l, 16); l += __shfl_xor(l, 32);
        l += __builtin_amdgcn_exp2f(sk2 - mrun[qs]);
        const float inv = 1.0f / l;
        const size_t row = (size_t)b * SEQ + n * 128 + wq * 32 + qs * 16 + fre;
        float sq = 0.f;
#pragma unroll
        for (int d = 0; d < 4; ++d) {
            const int col = h * 64 + d * 16 + 4 * fqe;
            const u32x2 g = gsv[qs][d];
            const f32x4 ng = ngv[d];
            const float v0 = oacc[d][qs][0] * inv * bflo(g.x), v1 = oacc[d][qs][1] * inv * bfhi(g.x), v2 = oacc[d][qs][2] * inv * bflo(g.y), v3 = oacc[d][qs][3] * inv * bfhi(g.y);
            sq += v0 * v0 + v1 * v1 + v2 * v2 + v3 * v3;
            u32x2 w; w.x = pk2(v0 * ng[0], v1 * ng[1]); w.y = pk2(v2 * ng[2], v3 * ng[3]);
            *(u32x2*)(HRAW + row * DM + col) = w;
        }
        sq += __shfl_xor(sq, 16); sq += __shfl_xor(sq, 32);
        if (fq == 0) ((float*)(p.ws + WS_SSQA))[row * 16 + h] = sq;
    }
    }
}

__device__ __forceinline__ void conv_phase(const Params& p, LAS unsigned char* lds) {
    const bf16_t* XBC = (const bf16_t*)(p.ws + WS_XBC); bf16_t* XT = (bf16_t*)(p.ws + WS_XT); bf16_t* BT = (bf16_t*)(p.ws + WS_BT); bf16_t* BCN = (bf16_t*)(p.ws + WS_BCN);
    const int tid = opaque_tid();
    const int G16 = (int)gridDim.x >> 4;
    if ((int)blockIdx.x >= G16 * 16) return;
    const int cb = blockIdx.x & 15, ch0 = cb * 128;
    const int t = tid & 31, cs = tid >> 5, ch = ch0 + cs * 8;
    float w0[8], w1[8], w2[8], wb[8];
#pragma unroll
    for (int e = 0; e < 8; ++e) { w0[e] = p.conv_w[ch + e]; w1[e] = p.conv_w[DM + ch + e]; w2[e] = p.conv_w[2 * DM + ch + e]; wb[e] = p.conv_b[ch + e]; }
    LAS unsigned char* R = lds;
    LAS unsigned char* Tt = lds + 18432;
    LAS unsigned char* Nn = lds + 18432 + 18432;
    u32x4 raw[3];
    auto tile_info = [&](int tt, int& b, int& tok0, int& seqlen, int& rowbase, int& sbase) {
        if (tt < 256) { b = tt >> 6; tok0 = (tt & 63) * 64; seqlen = SEQ; rowbase = b * SEQ; sbase = 0; }
        else { const int t2 = tt - 256; b = t2 >> 2; tok0 = (t2 & 3) * 64; seqlen = NCTX; rowbase = NX + b * NCTX; sbase = SEQ; }
    };
    auto gload = [&](int tt) {
        int b, tok0, seqlen, rowbase, sbase; tile_info(tt, b, tok0, seqlen, rowbase, sbase);
#pragma unroll
        for (int i = 0; i < 3; ++i) {
            const int idx = tid + 512 * i, rr = idx >> 4, sl = idx & 15, tok = tok0 - 1 + rr;
            raw[i] = (u32x4){0u, 0u, 0u, 0u};
            if (idx < 66 * 16 && tok >= 0 && tok < seqlen) raw[i] = *(const u32x4*)(XBC + (size_t)(rowbase + tok) * DM + ch0 + sl * 8);
        }
    };
    int tt = blockIdx.x >> 4;
    gload(tt);
    for (; tt < 272; tt += G16) {
        int b, tok0, seqlen, rowbase, sbase; tile_info(tt, b, tok0, seqlen, rowbase, sbase);
#pragma unroll
        for (int i = 0; i < 3; ++i) { const int idx = tid + 512 * i, rr = idx >> 4, sl = idx & 15; if (idx < 66 * 16) *(LAS u32x4*)(R + rr * 272 + sl * 16) = raw[i]; }
        __syncthreads();
        if (tt + G16 < 272) gload(tt + G16);
        {
            u32x4 r[4];
#pragma unroll
            for (int i = 0; i < 4; ++i) r[i] = *(const LAS u32x4*)(R + (2 * t + i) * 272 + cs * 16);
            float u0[8], u1[8];
#pragma unroll
            for (int e2 = 0; e2 < 4; ++e2) {
                float x[4][2];
#pragma unroll
                for (int i = 0; i < 4; ++i) { x[i][0] = bflo(r[i][e2]); x[i][1] = bfhi(r[i][e2]); }
#pragma unroll
                for (int hh = 0; hh < 2; ++hh) {
                    const int e = e2 * 2 + hh;
                    u0[e] = siluf(wb[e] + w0[e] * x[0][hh] + w1[e] * x[1][hh] + w2[e] * x[2][hh]);
                    u1[e] = siluf(wb[e] + w0[e] * x[1][hh] + w1[e] * x[2][hh] + w2[e] * x[3][hh]);
                }
            }
            if (cb < 12) {
#pragma unroll
                for (int e = 0; e < 8; ++e) *(LAS unsigned*)(Tt + (cs * 8 + e) * 144 + t * 4) = pk2(u0[e], u1[e]);
            }
            if (cb >= 8) {
                u32x4 o0, o1;
                o0.x = pk2(u0[0], u0[1]); o0.y = pk2(u0[2], u0[3]); o0.z = pk2(u0[4], u0[5]); o0.w = pk2(u0[6], u0[7]);
                o1.x = pk2(u1[0], u1[1]); o1.y = pk2(u1[2], u1[3]); o1.z = pk2(u1[4], u1[5]); o1.w = pk2(u1[6], u1[7]);
                *(LAS u32x4*)(Nn + (2 * t) * 272 + cs * 16) = o0; *(LAS u32x4*)(Nn + (2 * t + 1) * 272 + cs * 16) = o1;
            }
        }
        __syncthreads();
        if (cb < 12) {
            bf16_t* dst = (cb < 8) ? XT + ((size_t)b * 1024 + ch0) * TOKP : BT + ((size_t)b * 512 + (ch0 - 1024)) * TOKP;
#pragma unroll
            for (int i = 0; i < 2; ++i) {
                const int idx = tid + 512 * i, chl = idx >> 3, sl = idx & 7;
                *(u32x4*)(dst + (size_t)chl * TOKP + sbase + tok0 + sl * 8) = *(const LAS u32x4*)(Tt + chl * 144 + sl * 16);
            }
        }
        if (cb >= 8) {
#pragma unroll
            for (int i = 0; i < 2; ++i) {
                const int idx = tid + 512 * i, tk = idx >> 4, sl = idx & 15;
                *(u32x4*)(BCN + (size_t)(rowbase + tok0 + tk) * 1024 + (ch0 - 1024) + sl * 8) = *(const LAS u32x4*)(Nn + tk * 272 + sl * 16);
            }
        }
    }
    __syncthreads();
}

__device__ __forceinline__ float chunk_tables_hd(const Params& p, LAS float* tab, int row0, int hg, int dir);
__device__ __forceinline__ float chunk_tables(const Params& p, LAS float* tab, int row0, int g) {
    const int w = opaque_tid() >> 6;
    return chunk_tables_hd(p, tab, row0, g * 4 + (w >> 1), w & 1);
}
__device__ __forceinline__ float chunk_tables_hd(const Params& p, LAS float* tab, int row0, int hg, int dir) {
    const float* DT = (const float*)(p.ws + WS_DT);
    const int tid_ = opaque_tid(), lane = tid_ & 63, w = tid_ >> 6;
    const float A = -__expf(dir ? p.a_log_b[hg] : p.a_log_f[hg]);
    const float d0 = DT[(size_t)(row0 + 2 * lane) * 32 + dir * 16 + hg], d1 = DT[(size_t)(row0 + 2 * lane + 1) * 32 + dir * 16 + hg];
    const float a0 = d0 * A, a1 = d1 * A;
    float inc = a0 + a1;
#pragma unroll
    for (int o = 1; o < 64; o <<= 1) { const float t = __shfl_up(inc, o); if (lane >= o) inc += t; }
    const float total = __shfl(inc, 63);
    float c0 = inc - a1, c1 = inc;
    if (dir) { c0 = total - c0 + a0; c1 = total - c1 + a1; }
    LAS float* tb = tab + w * 256;
    tb[2 * lane] = c0; tb[2 * lane + 1] = c1; tb[128 + 2 * lane] = d0; tb[128 + 2 * lane + 1] = d1;
    return total;
}

__device__ __forceinline__ void s1_item(const Params& p, LAS unsigned char* lds, int item) {
    const bf16_t* XT = (const bf16_t*)(p.ws + WS_XT); const bf16_t* BT = (const bf16_t*)(p.ws + WS_BT);
    bf16_t* CS = (bf16_t*)(p.ws + WS_CS); float* DEC = (float*)(p.ws + WS_DEC);
    const int tid = opaque_tid(), lane = tid & 63, w = tid >> 6, fr = lane & 15, fq = lane >> 4;
    const int g = item & 3, cid = (item >> 2) % NSLOT, b = (item >> 2) / NSLOT;
    int row0, s0, slot_f, slot_b;
    if (cid < 2) { row0 = NX + b * NCTX + cid * 128; s0 = SEQ + cid * 128; slot_f = cid; slot_b = 1 - cid; }
    else { const int c = cid - 2; row0 = b * SEQ + c * 128; s0 = c * 128; slot_f = 2 + c; slot_b = 2 + (31 - c); }
    LAS unsigned char* Xl = lds;
    LAS unsigned char* Bl = lds + 65536;
    LAS float* tab = (LAS float*)(lds + 98304);
    LAS float* wS = (LAS float*)(lds + 98304 + 8192);
#pragma unroll
    for (int i = 0; i < 8; ++i) { const int idx = tid + 512 * i, r = idx >> 4, sl = idx & 15;
        *(LAS u32x4*)(Xl + r * 256 + ((sl ^ (r & 15)) << 4)) = *(const u32x4*)(XT + ((size_t)b * 1024 + g * 256 + r) * TOKP + s0 + sl * 8); }
#pragma unroll
    for (int i = 0; i < 4; ++i) { const int idx = tid + 512 * i, r = idx >> 4, sl = idx & 15, rs = (r & ~31) + pg8::perm32(r & 31);
        *(LAS u32x4*)(Bl + r * 256 + ((sl ^ (r & 15)) << 4)) = *(const u32x4*)(BT + ((size_t)b * 512 + g * 128 + rs) * TOKP + s0 + sl * 8); }
    const float total = chunk_tables(p, tab, row0, g);
    const int hl = w >> 1, dir = w & 1, hg = g * 4 + hl, slot = dir ? slot_b : slot_f;
    {
        LAS float* tb = tab + w * 256;
#pragma unroll
        for (int i = 0; i < 2; ++i) { const int l = 2 * lane + i; wS[w * 128 + l] = DBG_W(tb[128 + l] * __expf(total - tb[l])); }
        if (lane == 0) DEC[((b * 2 + dir) * NSLOT + slot) * 16 + hg] = __expf(total);
    }
    __syncthreads();
    bf16_t* dst = CS + ((size_t)((b * 2 + dir) * NSLOT + slot) * 16 + hg) * 8192;
#pragma unroll 1
    for (int pt = 0; pt < 4; ++pt) {
        f32x4 acc[8];
#pragma unroll
        for (int nt = 0; nt < 8; ++nt) acc[nt] = (f32x4){0.f, 0.f, 0.f, 0.f};
#pragma unroll
        for (int ks = 0; ks < 4; ++ks) {
            const int xr = hl * 64 + pt * 16 + fr;
            U8 xa; xa.u = *(const LAS u32x4*)(Xl + xr * 256 + (((ks * 4 + fq) ^ fr) << 4));
            const f32x4 wa = *(const LAS f32x4*)(wS + w * 128 + ks * 32 + fq * 8), wb = *(const LAS f32x4*)(wS + w * 128 + ks * 32 + fq * 8 + 4);
            xa.u.x = pk2(bflo(xa.u.x) * wa[0], bfhi(xa.u.x) * wa[1]); xa.u.y = pk2(bflo(xa.u.y) * wa[2], bfhi(xa.u.y) * wa[3]);
            xa.u.z = pk2(bflo(xa.u.z) * wb[0], bfhi(xa.u.z) * wb[1]); xa.u.w = pk2(bflo(xa.u.w) * wb[2], bfhi(xa.u.w) * wb[3]);
#pragma unroll
            for (int nt = 0; nt < 8; ++nt) {
                const bf16x8 bb = *(const LAS bf16x8*)(Bl + (nt * 16 + fr) * 256 + (((ks * 4 + fq) ^ fr) << 4));
                acc[nt] = MFMA16(bb, xa.h, acc[nt]);
            }
        }
#pragma unroll
        for (int k2 = 0; k2 < 4; ++k2) {
            u32x4 o; o.x = pk2(acc[2 * k2][0], acc[2 * k2][1]); o.y = pk2(acc[2 * k2][2], acc[2 * k2][3]); o.z = pk2(acc[2 * k2 + 1][0], acc[2 * k2 + 1][1]); o.w = pk2(acc[2 * k2 + 1][2], acc[2 * k2 + 1][3]);
            *(u32x4*)(dst + (pt * 16 + fr) * 128 + k2 * 32 + 8 * fq) = o;
        }
    }
    __syncthreads();
}

__device__ __forceinline__ void s1_ctx_item(const Params& p, LAS unsigned char* lds, int sub) {
    const bf16_t* XT = (const bf16_t*)(p.ws + WS_XT); const bf16_t* BT = (const bf16_t*)(p.ws + WS_BT);
    bf16_t* CS = (bf16_t*)(p.ws + WS_CS); float* DEC = (float*)(p.ws + WS_DEC);
    const int tid = opaque_tid(), lane = tid & 63, w = tid >> 6, fr = lane & 15, fq = lane >> 4;
    const int dir = sub & 1, hl = (sub >> 1) & 3, g = (sub >> 3) & 3, cid = (sub >> 5) & 1, b = sub >> 6, hg = g * 4 + hl;
    const int row0 = NX + b * NCTX + cid * 128, s0 = SEQ + cid * 128, slot = dir ? (1 - cid) : cid;
    LAS unsigned char* Xl = lds;
    LAS unsigned char* Bl = lds + 65536;
    LAS float* tab = (LAS float*)(lds + 98304);
    LAS float* wS = (LAS float*)(lds + 98304 + 8192);
#pragma unroll
    for (int i = 0; i < 2; ++i) { const int idx = tid + 512 * i, r = idx >> 4, sl = idx & 15;
        *(LAS u32x4*)(Xl + r * 256 + ((sl ^ (r & 15)) << 4)) = *(const u32x4*)(XT + ((size_t)b * 1024 + hg * 64 + r) * TOKP + s0 + sl * 8); }
#pragma unroll
    for (int i = 0; i < 4; ++i) { const int idx = tid + 512 * i, r = idx >> 4, sl = idx & 15, rs = (r & ~31) + pg8::perm32(r & 31);
        *(LAS u32x4*)(Bl + r * 256 + ((sl ^ (r & 15)) << 4)) = *(const u32x4*)(BT + ((size_t)b * 512 + g * 128 + rs) * TOKP + s0 + sl * 8); }
    const float total = chunk_tables_hd(p, tab, row0, hg, dir);
    {
        LAS float* tb = tab + w * 256;
#pragma unroll
        for (int i = 0; i < 2; ++i) { const int l = 2 * lane + i; wS[w * 128 + l] = tb[128 + l] * __expf(total - tb[l]); }
        if (tid == 0) DEC[((b * 2 + dir) * NSLOT + slot) * 16 + hg] = __expf(total);
    }
    __syncthreads();
    bf16_t* dst = CS + ((size_t)((b * 2 + dir) * NSLOT + slot) * 16 + hg) * 8192;
    const int pt = w >> 1, nt0 = (w & 1) * 4;
    f32x4 acc[4];
#pragma unroll
    for (int nt = 0; nt < 4; ++nt) acc[nt] = (f32x4){0.f, 0.f, 0.f, 0.f};
#pragma unroll
    for (int ks = 0; ks < 4; ++ks) {
        U8 xa; xa.u = *(const LAS u32x4*)(Xl + (pt * 16 + fr) * 256 + (((ks * 4 + fq) ^ fr) << 4));
        const f32x4 wa = *(const LAS f32x4*)(wS + w * 128 + ks * 32 + fq * 8), wb = *(const LAS f32x4*)(wS + w * 128 + ks * 32 + fq * 8 + 4);
        xa.u.x = pk2(bflo(xa.u.x) * wa[0], bfhi(xa.u.x) * wa[1]); xa.u.y = pk2(bflo(xa.u.y) * wa[2], bfhi(xa.u.y) * wa[3]);
        xa.u.z = pk2(bflo(xa.u.z) * wb[0], bfhi(xa.u.z) * wb[1]); xa.u.w = pk2(bflo(xa.u.w) * wb[2], bfhi(xa.u.w) * wb[3]);
#pragma unroll
        for (int nt = 0; nt < 4; ++nt) {
            const bf16x8 bb = *(const LAS bf16x8*)(Bl + ((nt0 + nt) * 16 + fr) * 256 + (((ks * 4 + fq) ^ fr) << 4));
            acc[nt] = MFMA16(bb, xa.h, acc[nt]);
        }
    }
#pragma unroll
    for (int k2 = 0; k2 < 2; ++k2) {
        u32x4 o; o.x = pk2(acc[2 * k2][0], acc[2 * k2][1]); o.y = pk2(acc[2 * k2][2], acc[2 * k2][3]); o.z = pk2(acc[2 * k2 + 1][0], acc[2 * k2 + 1][1]); o.w = pk2(acc[2 * k2 + 1][2], acc[2 * k2 + 1][3]);
        *(u32x4*)(dst + (pt * 16 + fr) * 128 + ((nt0 >> 1) + k2) * 32 + 8 * fq) = o;
    }
    __syncthreads();
}

__device__ __forceinline__ void phase5(const Params& p) {
    const bf16_t* __restrict__ CS = (const bf16_t*)(p.ws + WS_CS); bf16_t* __restrict__ PS = (bf16_t*)(p.ws + WS_PS); const float* __restrict__ DEC = (const float*)(p.ws + WS_DEC);
    const int tid_ = opaque_tid();
    for (int e8 = blockIdx.x * 512 + tid_; e8 < NB * 2 * 16 * 1024; e8 += gridDim.x * 512) {
        const int n8 = (e8 & 1023) * 8, hg = (e8 >> 10) & 15, bd = e8 >> 14;
        float s[8];
#pragma unroll
        for (int e = 0; e < 8; ++e) s[e] = 0.f;
#pragma unroll 1
        for (int s0 = 0; s0 < 33; s0 += 11) {
            u32x4 cv[11]; float dv[11];
#pragma unroll
            for (int k = 0; k < 11; ++k) {
                const int slot = s0 + k;
                cv[k] = *(const u32x4*)(CS + ((size_t)(bd * NSLOT + slot) * 16 + hg) * 8192 + n8); dv[k] = DEC[(bd * NSLOT + slot) * 16 + hg];
            }
#pragma unroll
            for (int k = 0; k < 11; ++k) {
                const int slot = s0 + k;
                if (slot >= 2) { u32x4 o; o.x = pk2(s[0], s[1]); o.y = pk2(s[2], s[3]); o.z = pk2(s[4], s[5]); o.w = pk2(s[6], s[7]); *(u32x4*)(PS + ((size_t)(bd * NSLOT + slot) * 16 + hg) * 8192 + n8) = o; }
                const float d = dv[k];
                s[0] = d * s[0] + bflo(cv[k].x); s[1] = d * s[1] + bfhi(cv[k].x); s[2] = d * s[2] + bflo(cv[k].y); s[3] = d * s[3] + bfhi(cv[k].y);
                s[4] = d * s[4] + bflo(cv[k].z); s[5] = d * s[5] + bfhi(cv[k].z); s[6] = d * s[6] + bflo(cv[k].w); s[7] = d * s[7] + bfhi(cv[k].w);
            }
        }
        { u32x4 o; o.x = pk2(s[0], s[1]); o.y = pk2(s[2], s[3]); o.z = pk2(s[4], s[5]); o.w = pk2(s[6], s[7]); *(u32x4*)(PS + ((size_t)(bd * NSLOT + 33) * 16 + hg) * 8192 + n8) = o; }
    }
}

__device__ __forceinline__ void s3_item(const Params& p, LAS unsigned char* lds, int item) {
    const bf16_t* XT = (const bf16_t*)(p.ws + WS_XT); const bf16_t* BCN = (const bf16_t*)(p.ws + WS_BCN); const bf16_t* PS = (const bf16_t*)(p.ws + WS_PS);
    const bf16_t* ZS = (const bf16_t*)(p.ws + WS_ZS); bf16_t* HRAW = (bf16_t*)(p.ws + WS_HRAW);
    const int tid = opaque_tid(), lane = tid & 63, w = tid >> 6, fr = lane & 15, fq = lane >> 4;
    const int g = item & 3, c = (item >> 2) & 31, b = item >> 7;
    const int row0 = b * SEQ + c * 128, s0 = c * 128, slot_f = 2 + c, slot_b = 2 + (31 - c);
    LAS unsigned char* Xl = lds;
    LAS unsigned char* Cl = lds + 65536;
    LAS unsigned char* Bl = lds + 98304;
    LAS float* tab = (LAS float*)(lds + 131072);
#pragma unroll
    for (int i = 0; i < 8; ++i) { const int idx = tid + 512 * i, r = idx >> 4, sl = idx & 15, kb_ = sl >> 2, s_ = sl & 3, hf_ = (s_ >> 1) * 8;
        const u32x4 xv_ = *(const u32x4*)(XT + ((size_t)b * 1024 + g * 256 + r) * TOKP + s0 + sl * 8);
        *(LAS u32x2*)(Xl + r * 256 + (((kb_ * 4 + ((2 * s_) & 3)) ^ (r & 15)) << 4) + hf_) = (u32x2){xv_.x, xv_.y};
        *(LAS u32x2*)(Xl + r * 256 + (((kb_ * 4 + ((2 * s_ + 1) & 3)) ^ (r & 15)) << 4) + hf_) = (u32x2){xv_.z, xv_.w}; }
#pragma unroll
    for (int i = 0; i < 4; ++i) { const int idx = tid + 512 * i, r = idx >> 4, sl = idx & 15;
        *(LAS u32x4*)(Bl + r * 256 + ((sl ^ (r & 15)) << 4)) = *(const u32x4*)(BCN + (size_t)(row0 + r) * 1024 + g * 128 + sl * 8);
        *(LAS u32x4*)(Cl + r * 256 + ((sl ^ (r & 15)) << 4)) = *(const u32x4*)(BCN + (size_t)(row0 + r) * 1024 + 512 + g * 128 + sl * 8); }
    u32x4 pv[4];
    auto pload = [&](int hl_) {
#pragma unroll
        for (int i = 0; i < 4; ++i) {
            const int idx = tid + 512 * i, dir = idx >> 10, r = (idx >> 4) & 63, sl = idx & 15;
            const int slot = dir ? slot_b : slot_f;
            pv[i] = *(const u32x4*)(PS + ((size_t)((b * 2 + dir) * NSLOT + slot) * 16 + g * 4 + hl_) * 8192 + r * 128 + sl * 8);
        }
    };
    pload(0);
    chunk_tables(p, tab, row0, g);
    __syncthreads();
    bf16x8 cf[4];
#pragma unroll
    for (int ks = 0; ks < 4; ++ks) cf[ks] = *(const LAS bf16x8*)(Cl + (w * 16 + fr) * 256 + (((ks * 4 + fq) ^ fr) << 4));
    f32x4 cb[8];
#pragma unroll
    for (int st = 0; st < 8; ++st) {
        cb[st] = (f32x4){0.f, 0.f, 0.f, 0.f};
#pragma unroll
        for (int ks = 0; ks < 4; ++ks) {
            const bf16x8 bf = *(const LAS bf16x8*)(Bl + (st * 16 + fr) * 256 + (((ks * 4 + fq) ^ fr) << 4));
            cb[st] = MFMA16(bf, cf[ks], cb[st]);
        }
    }
    __syncthreads();
    const int l = w * 16 + fr;
#pragma unroll 1
    for (int hl = 0; hl < 4; ++hl) {
        const int hg = g * 4 + hl;
#pragma unroll
        for (int i = 0; i < 4; ++i) {
            const int idx = tid + 512 * i, dir = idx >> 10, r = (idx >> 4) & 63, sl = idx & 15;
            *(LAS u32x4*)(Bl + dir * 16384 + r * 256 + ((sl ^ (r & 15)) << 4)) = pv[i];
        }
        __syncthreads();
        if (hl < 3) pload(hl + 1);
        u32x2 zv[4]; f32x4 ngv[4];
#pragma unroll
        for (int q = 0; q < 4; ++q) { zv[q] = *(const u32x2*)(ZS + ((size_t)row0 + l) * 1024 + hg * 64 + q * 16 + 4 * fq); ngv[q] = *(const f32x4*)(p.ssd_norm_g + hg * 64 + q * 16 + 4 * fq); }
        LAS float* tf = tab + (hl * 2) * 256; LAS float* tbk = tab + (hl * 2 + 1) * 256;
        const float cfl = tf[l], cbl = tbk[l], dsum = tf[128 + l] + tbk[128 + l], dsk = p.d_skip[hg];
        bf16x8 wf[4];
        int lq = l, fqw = fq; asm volatile("" : "+v"(lq), "+v"(fqw));
#pragma unroll
        for (int sb = 0; sb < 4; ++sb) {
            float wv[8];
#pragma unroll
            for (int half = 0; half < 2; ++half) {
                const int st = 2 * sb + half, sbase = st * 16 + 4 * fq;
                const f32x4 csf = *(const LAS f32x4*)(tf + sbase), dtf = *(const LAS f32x4*)(tf + 128 + sbase);
                const f32x4 csb = *(const LAS f32x4*)(tbk + sbase), dtb = *(const LAS f32x4*)(tbk + 128 + sbase);
#pragma unroll
                for (int j = 0; j < 4; ++j) {
                    const int s = st * 16 + 4 * fqw + j; const float cbv = cb[st][j];
                    const bool fw = s < lq;
                    const float arg = fw ? (cfl - csf[j]) : (cbl - csb[j]), dts = fw ? dtf[j] : dtb[j];
                    float v = cbv * __expf(arg) * dts;
                    if (s == lq) v = cbv * dsum + dsk;
                    wv[half * 4 + j] = v;
                }
            }
            U8 t; t.u.x = pk2(wv[0], wv[1]); t.u.y = pk2(wv[2], wv[3]); t.u.z = pk2(wv[4], wv[5]); t.u.w = pk2(wv[6], wv[7]);
            wf[sb] = t.h;
        }
        const float ef = __expf(cfl), eb = __expf(cbl);
        float sq = 0.f;
#pragma unroll 1
        for (int pt = 0; pt < 4; ++pt) {
            f32x4 y = (f32x4){0.f, 0.f, 0.f, 0.f}, t0 = y, t1 = y;
            const int xr = hl * 64 + pt * 16 + fr;
#pragma unroll
            for (int sb = 0; sb < 4; ++sb) {
                U8 xa; xa.u = *(const LAS u32x4*)(Xl + xr * 256 + (((4 * sb + fq) ^ fr) << 4));
                y = MFMA16(xa.h, wf[sb], y);
            }
#pragma unroll
            for (int ks = 0; ks < 4; ++ks) {
                const bf16x8 pa = *(const LAS bf16x8*)(Bl + (pt * 16 + fr) * 256 + (((ks * 4 + fq) ^ fr) << 4));
                const bf16x8 pb = *(const LAS bf16x8*)(Bl + 16384 + (pt * 16 + fr) * 256 + (((ks * 4 + fq) ^ fr) << 4));
                t0 = MFMA16(pa, cf[ks], t0); t1 = MFMA16(pb, cf[ks], t1);
            }
            y += ef * t0 + eb * t1;
            const size_t row = (size_t)row0 + l; const int col = hg * 64 + pt * 16 + 4 * fq;
            const u32x2 z = (pt == 0) ? zv[0] : (pt == 1) ? zv[1] : (pt == 2) ? zv[2] : zv[3];
            const f32x4 ng = (pt == 0) ? ngv[0] : (pt == 1) ? ngv[1] : (pt == 2) ? ngv[2] : ngv[3];
            const float v0 = y[0] * bflo(z.x), v1 = y[1] * bfhi(z.x), v2 = y[2] * bflo(z.y), v3 = y[3] * bfhi(z.y);
            sq += v0 * v0 + v1 * v1 + v2 * v2 + v3 * v3;
            u32x2 o; o.x = pk2(v0 * ng[0], v1 * ng[1]); o.y = pk2(v2 * ng[2], v3 * ng[3]);
            *(u32x2*)(HRAW + row * DM + 1024 + col) = o;
        }
        sq += __shfl_xor(sq, 16); sq += __shfl_xor(sq, 32);
        if (fq == 0) ((float*)(p.ws + WS_SSQS))[((size_t)row0 + l) * 16 + hg] = sq;
        __syncthreads();
    }
}

__device__ __forceinline__ void phase7(const Params& p) {
    bf16_t* HRAW = (bf16_t*)(p.ws + WS_HRAW);
    const int tid_ = opaque_tid(), lane = tid_ & 63, wid = tid_ >> 6;
    const int stride = gridDim.x * 8;
    for (int row0 = blockIdx.x * 8 + wid; row0 < NX; row0 += 4 * stride) {
        u32x4 v[4][4]; float ss[4][2];
#pragma unroll
        for (int r = 0; r < 4; ++r) {
            const int row = (row0 + r * stride < NX) ? row0 + r * stride : row0;
#pragma unroll
            for (int i = 0; i < 4; ++i) v[r][i] = *(const u32x4*)(HRAW + (size_t)row * DM + (i * 64 + lane) * 8);
        }
#pragma unroll
        for (int r = 0; r < 4; ++r) {
            ss[r][0] = 0.f; ss[r][1] = 0.f;
#pragma unroll
            for (int i = 0; i < 4; ++i)
#pragma unroll
                for (int e = 0; e < 4; ++e) { const float a = bflo(v[r][i][e]), c = bfhi(v[r][i][e]); ss[r][i >> 1] += a * a + c * c; }
            ss[r][0] = wave_sum(ss[r][0]); ss[r][1] = wave_sum(ss[r][1]);
        }
#pragma unroll
        for (int r = 0; r < 4; ++r) {
            const int row = row0 + r * stride;
            if (row < NX) {
                const float r0 = rsqrtf(ss[r][0] * (1.0f / 1024.0f) + EPS), r1 = rsqrtf(ss[r][1] * (1.0f / 1024.0f) + EPS);
#pragma unroll
                for (int i = 0; i < 4; ++i) {
                    const int k = (i * 64 + lane) * 8; const float rs = (i < 2) ? r0 : r1;
                    const float* gp = (i < 2) ? p.att_norm_g + k : p.ssd_norm_g + (k - 1024);
                    const f32x4 g0 = *(const f32x4*)gp, g1 = *(const f32x4*)(gp + 4);
                    u32x4 o;
                    o.x = pk2(bflo(v[r][i].x) * rs * g0[0], bfhi(v[r][i].x) * rs * g0[1]); o.y = pk2(bflo(v[r][i].y) * rs * g0[2], bfhi(v[r][i].y) * rs * g0[3]);
                    o.z = pk2(bflo(v[r][i].z) * rs * g1[0], bfhi(v[r][i].z) * rs * g1[1]); o.w = pk2(bflo(v[r][i].w) * rs * g1[2], bfhi(v[r][i].w) * rs * g1[3]);
                    *(u32x4*)(HRAW + (size_t)row * DM + k) = o;
                }
            }
        }
    }
}

__device__ __forceinline__ void phase9(const Params& p) {
    const bf16_t* RB = (const bf16_t*)(p.ws + WS_RB);
    const int tid_ = opaque_tid(), lane = tid_ & 63, wid = tid_ >> 6;
    const int stride = gridDim.x * 8;
    for (int row0 = blockIdx.x * 8 + wid; row0 < NX; row0 += 4 * stride) {
        u32x4 v[4][4]; float ss[4];
#pragma unroll
        for (int r = 0; r < 4; ++r) {
            const int row = (row0 + r * stride < NX) ? row0 + r * stride : row0;
#pragma unroll
            for (int i = 0; i < 4; ++i) v[r][i] = *(const u32x4*)(RB + (size_t)row * DM + (i * 64 + lane) * 8);
        }
#pragma unroll
        for (int r = 0; r < 4; ++r) {
            ss[r] = 0.f;
#pragma unroll
            for (int i = 0; i < 4; ++i)
#pragma unroll
                for (int e = 0; e < 4; ++e) { const float a = bflo(v[r][i][e]), c = bfhi(v[r][i][e]); ss[r] += a * a + c * c; }
            ss[r] = wave_sum(ss[r]);
        }
#pragma unroll
        for (int r = 0; r < 4; ++r) {
            const int row = row0 + r * stride;
            if (row < NX) {
                const float rstd = rsqrtf(ss[r] * (1.0f / DM) + EPS);
#pragma unroll
                for (int i = 0; i < 4; ++i) {
                    const int k = (i * 64 + lane) * 8;
                    const f32x4 g0 = *(const f32x4*)(p.final_norm_g + k), g1 = *(const f32x4*)(p.final_norm_g + k + 4);
                    f32x4 o0, o1;
                    o0[0] = bflo(v[r][i].x) * rstd * g0[0]; o0[1] = bfhi(v[r][i].x) * rstd * g0[1]; o0[2] = bflo(v[r][i].y) * rstd * g0[2]; o0[3] = bfhi(v[r][i].y) * rstd * g0[3];
                    o1[0] = bflo(v[r][i].z) * rstd * g1[0]; o1[1] = bfhi(v[r][i].z) * rstd * g1[1]; o1[2] = bflo(v[r][i].w) * rstd * g1[2]; o1[3] = bfhi(v[r][i].w) * rstd * g1[3];
                    *(f32x4*)(p.out + (size_t)row * DM + k) = o0; *(f32x4*)(p.out + (size_t)row * DM + k + 4) = o1;
                }
            }
        }
    }
}

#define XB_TMO      128
#define XB_XCNT(j)  (256  + 64 * (j))
#define XB_XSUB(j)  (1280 + 64 * (j))
#define XB_XGEN(j)  (2304 + 64 * (j))
#define XB_TOP      3328
#define XB_TOPGEN   3392
#define XCD_BAR_WORDS 3456
#define XB_SPIN_CAP (1u << 22)
__device__ __forceinline__ unsigned xb_ld(unsigned* p)              { return __hip_atomic_load(p, __ATOMIC_RELAXED, __HIP_MEMORY_SCOPE_AGENT); }
__device__ __forceinline__ unsigned xb_add(unsigned* p, unsigned v) { return __hip_atomic_fetch_add(p, v, __ATOMIC_RELAXED, __HIP_MEMORY_SCOPE_AGENT); }
__device__ __forceinline__ unsigned xb_xcc_id() { return (unsigned)__builtin_amdgcn_s_getreg((3 << 11) | 20) & 0xFu; }
#define XB_SPIN(cond, bar) do { unsigned _sp = 0; while (cond) { __builtin_amdgcn_s_sleep(1); \
    if ((++_sp & 255u) == 0u) { if (xb_ld(&(bar)[XB_TMO])) break; if (_sp > XB_SPIN_CAP) { atomicAdd(&(bar)[XB_TMO], 1u); break; } } } } while (0)
struct XcdBarrier { unsigned* bar; unsigned x; volatile LAS unsigned* st; };
__device__ __forceinline__ XcdBarrier xcd_barrier_post(unsigned* bar, volatile LAS unsigned* st) {
    XcdBarrier b; b.bar = bar; b.x = xb_xcc_id(); b.st = st;
    if (threadIdx.x == 0) (void)xb_add(&bar[XB_XCNT(b.x)], 1u);
    return b;
}
__device__ __forceinline__ void xcd_barrier_complete(unsigned* bar, unsigned x, unsigned& nloc, unsigned& nx) {
    const unsigned G = gridDim.x * gridDim.y * gridDim.z;
    unsigned sum, cnt, mine, sp = 0u;
    for (;;) {
        sum = 0u; cnt = 0u; mine = 0u;
#pragma unroll
        for (unsigned j = 0; j < 16; ++j) { const unsigned c = xb_ld(&bar[XB_XCNT(j)]); sum += c; cnt += (c > 0u) ? 1u : 0u; mine = (j == x) ? c : mine; }
        if (sum == G) break;
        __builtin_amdgcn_s_sleep(1);
        if ((++sp & 255u) == 0u) { if (xb_ld(&bar[XB_TMO])) break; if (sp > XB_SPIN_CAP) { atomicAdd(&bar[XB_TMO], 1u); break; } }
    }
    nloc = mine > 0u ? mine : 1u; nx = cnt > 0u ? cnt : 1u;
}
__device__ __forceinline__ void xcd_barrier(const XcdBarrier& b) {
    asm volatile("s_waitcnt vmcnt(0)" ::: "memory");
    __syncthreads();
    if (threadIdx.x == 0) {
        unsigned* bar = b.bar;
        __builtin_amdgcn_s_waitcnt(0);
        unsigned nloc = b.st[0], nx = b.st[1];
        if (nloc == 0u) { xcd_barrier_complete(bar, b.x, nloc, nx); b.st[0] = nloc; b.st[1] = nx; }
        const unsigned old = xb_add(&bar[XB_XSUB(b.x)], 1u);
        const unsigned gen = old / nloc;
        if (old + 1u == (gen + 1u) * nloc) {
            __builtin_amdgcn_fence(__ATOMIC_RELEASE, "agent");
            asm volatile("s_waitcnt vmcnt(0)" ::: "memory");
            const unsigned og = xb_add(&bar[XB_TOP], 1u);
            const unsigned tg = og / nx;
            if (og + 1u == (tg + 1u) * nx) xb_add(&bar[XB_TOPGEN], 1u);
            else XB_SPIN(xb_ld(&bar[XB_TOPGEN]) == tg, bar);
            __builtin_amdgcn_fence(__ATOMIC_ACQUIRE, "agent");
            xb_add(&bar[XB_XGEN(b.x)], 1u);
            asm volatile("s_waitcnt vmcnt(0)" ::: "memory");
        } else {
            XB_SPIN(xb_ld(&bar[XB_XGEN(b.x)]) == gen, bar);
            __builtin_amdgcn_fence(__ATOMIC_ACQUIRE, "agent");
            asm volatile("s_waitcnt vmcnt(0)" ::: "memory");
        }
    }
    __syncthreads();
}

constexpr int N_PHASES = 10;
__global__ void __launch_bounds__(512, 2) hybrid_fwd(Params p) {
    extern __shared__ __attribute__((aligned(16))) unsigned char shm[];
    LAS unsigned char* lds = (LAS unsigned char*)shm;
    cg::grid_group grid = cg::this_grid();
    volatile LAS unsigned* xst = (volatile LAS unsigned*)(lds + LDS_BYTES - 16);
    if (threadIdx.x == 0) { xst[0] = 0u; xst[1] = 0u; }
    __syncthreads();
    const XcdBarrier xb = xcd_barrier_post((unsigned*)(p.ws + WS_BAR), xst);
    if (p.ph_hi > 1000) grid.sync();
#ifdef ONLY_PHASE
#define RUN_PHASE(n) if ((n) == ONLY_PHASE && p.ph_lo <= (n) && (n) < p.ph_hi)
#elif defined(DBG_REPEAT)
#define RUN_PHASE(n) for (int rep_ = 0; rep_ < (((n) == DBG_REPEAT) ? 2 : 1); ++rep_, ((rep_ < (((n) == DBG_REPEAT) ? 2 : 1)) ? xcd_barrier(xb) : (void)0)) if (p.ph_lo <= (n) && (n) < p.ph_hi)
#else
#define RUN_PHASE(n) if (p.ph_lo <= (n) && (n) < p.ph_hi)
#endif
#define SEAM(n) if (p.ph_lo < (n) && (n) < p.ph_hi) xcd_barrier(xb)
#ifdef DBG_XSYNC
    for (int i_ = 0; i_ < DBG_XSYNC; ++i_) xcd_barrier(xb);
#endif
    RUN_PHASE(0) phase0(p, lds);
    SEAM(1);
    RUN_PHASE(1) phase1(p);
    SEAM(2);
    RUN_PHASE(2) {
        phase2_dt(p);
        pg8::Gemm g; g.A = (const bf16_t*)(p.ws + WS_XN); g.Bt = (const bf16_t*)(p.ws + WS_WINT); g.M = NR; g.N = NMAIN; g.K = DM;
        pg8::OrderIn S; S.G = (int)gridDim.x; S.c = (int)blockIdx.x;
        EpiIn E; E.ws = p.ws; E.ropeC = (const float*)(p.ws + WS_ROPEC); E.ropeS = (const float*)(p.ws + WS_ROPES);
        pg8::gemm_phase<EpiIn, pg8::OrderIn>(lds, g, S, E);
    }
    SEAM(3);
    RUN_PHASE(3) {
        constexpr int N_ATT = NB * 32 * 8;
        attn_phase(p, lds, N_ATT);
        conv_phase(p, lds);
#ifdef DBG_CONV2
        conv_phase(p, lds);
#endif
    }
    SEAM(4);
    RUN_PHASE(4) {
        for (int it = blockIdx.x; it < NB * 32 * 4; it += gridDim.x) { const int g = it & 3, c = (it >> 2) & 31, b = it >> 7; s1_item(p, lds, ((b * NSLOT + 2 + c) << 2) | g); }
        for (int sub = blockIdx.x; sub < 256; sub += gridDim.x) s1_ctx_item(p, lds, sub);
    }
    SEAM(5);
    RUN_PHASE(5) phase5(p);
    SEAM(6);
    RUN_PHASE(6) { for (int item = blockIdx.x; item < NB * 32 * 4; item += gridDim.x) s3_item(p, lds, item); }
    SEAM(8);
    RUN_PHASE(8) {
        pg8::Gemm g; g.A = (const bf16_t*)(p.ws + WS_HRAW); g.Bt = (const bf16_t*)(p.ws + WS_WOUTT); g.M = NX; g.N = DM; g.K = DM;
        pg8::StaticOrder S; S.init(NX, DM, (int)gridDim.x, (int)blockIdx.x);
        {
            const int tid = opaque_tid();
            const float* SA = (const float*)(p.ws + WS_SSQA); const float* SY = (const float*)(p.ws + WS_SSQS);
            pg8::Unit uu;
            for (int i = 0; i < MAX_OUT_UNITS && S.next(i, uu); ++i) {
                if (tid < 256) {
                    const size_t row = (size_t)uu.pm * 256 + tid;
                    float sa = 0.f, sy = 0.f;
#pragma unroll
                    for (int q = 0; q < 4; ++q) { const f32x4 a4 = *(const f32x4*)(SA + row * 16 + q * 4), y4 = *(const f32x4*)(SY + row * 16 + q * 4); sa += (a4[0] + a4[1]) + (a4[2] + a4[3]); sy += (y4[0] + y4[1]) + (y4[2] + y4[3]); }
                    const float ra = rsqrtf(sa * (1.0f / 1024.0f) + EPS), ry = rsqrtf(sy * (1.0f / 1024.0f) + EPS);
                    ((LAS float*)(lds + RAT_OFF))[i * 256 + tid] = ra / ry; ((LAS float*)(lds + RSY_OFF))[i * 256 + tid] = ry;
                }
            }
            __syncthreads();
        }
        EpiOut E; E.x = p.x; E.mod = (const float*)(p.ws + WS_MOD); E.rb = (bf16_t*)(p.ws + WS_RB); E.lds = lds;
        pg8::gemm_phase<EpiOut, pg8::StaticOrder>(lds, g, S, E);
    }
    SEAM(9);
    RUN_PHASE(9) phase9(p);
#ifdef DBG_STOP
    RUN_PHASE(10) {
        const int tid_ = opaque_tid(), lane = tid_ & 63, wid = tid_ >> 6;
        for (int row = blockIdx.x * 8 + wid; row < NX; row += gridDim.x * 8) {
            const bf16_t* src = (const bf16_t*)(p.ws + DBG_DUMP) + (size_t)row * DM;
            for (int i = lane; i < DM; i += 64) { float v = __uint_as_float((unsigned)src[i] << 16); if (!(fabsf(v) < 1e30f)) v = 12345.0f; p.out[(size_t)row * DM + i] = v; }
        }
    }
#endif
}

extern "C" void kernel_launch(void* const* d_in, const int* in_sizes, int n_in, void* d_out, int out_size, void* d_ws, size_t ws_size, hipStream_t stream) {
    static int grid = 0;
    if (grid == 0) {
        if (n_in != 20 || in_sizes[0] != NX * DM || out_size != NX * DM || ws_size < WS_END) {
            fprintf(stderr, "kernel_launch: unexpected shapes (n_in %d, in0 %d, out %d, ws %zu need %zu)\n", n_in, n_in > 0 ? in_sizes[0] : -1, out_size, ws_size, (size_t)WS_END); grid = -1; return; }
        int dev = 0, cus = 0, per_cu = 0;
        hipGetDevice(&dev); hipDeviceGetAttribute(&cus, hipDeviceAttributeMultiprocessorCount, dev);
        if (hipFuncSetAttribute((const void*)hybrid_fwd, hipFuncAttributeMaxDynamicSharedMemorySize, LDS_BYTES) != hipSuccess) { fprintf(stderr, "kernel_launch: hipFuncSetAttribute failed\n"); grid = -1; return; }
        if (hipOccupancyMaxActiveBlocksPerMultiprocessor(&per_cu, (const void*)hybrid_fwd, 512, LDS_BYTES) != hipSuccess || per_cu < 1) { fprintf(stderr, "kernel_launch: occupancy query says %d\n", per_cu); per_cu = 1; }
        (void)hipGetLastError();
        grid = cus * 1;
    }
    if (grid < 0) return;
    Params p{};
    const float** pp = (const float**)&p;
    for (int i = 0; i < 20; ++i) pp[i] = (const float*)d_in[i];
    p.out = (float*)d_out; p.ws = (unsigned char*)d_ws;
    if (hipMemsetAsync((char*)d_ws + WS_BAR, 0, XCD_BAR_WORDS * 4, stream) != hipSuccess) { fprintf(stderr, "kernel_launch: memset of barrier words failed\n"); return; }
#if MK_LAUNCHES == 1
    p.ph_lo = 0; p.ph_hi = N_PHASES;
    void* args[] = {&p};
    hipError_t e = hipLaunchCooperativeKernel((const void*)hybrid_fwd, dim3(grid), dim3(512), args, LDS_BYTES, stream);
    if (e != hipSuccess) fprintf(stderr, "cooperative launch failed: %s (grid %d)\n", hipGetErrorString(e), grid);
#else
#ifdef DBG_STOP
    for (int ph = 0; ph <= DBG_STOP; ++ph) { p.ph_lo = ph; p.ph_hi = ph + 1; hipLaunchKernelGGL(hybrid_fwd, dim3(grid), dim3(512), LDS_BYTES, stream, p); }
    p.ph_lo = 10; p.ph_hi = 11; hipLaunchKernelGGL(hybrid_fwd, dim3(grid), dim3(512), LDS_BYTES, stream, p);
#else
    for (int ph = 0; ph < N_PHASES; ++ph) { p.ph_lo = ph; p.ph_hi = ph + 1; hipLaunchKernelGGL(hybrid_fwd, dim3(grid), dim3(512), LDS_BYTES, stream, p); }
#endif
#endif
}
```
